# Optimizing an MI355X kernel written in HIP

```python
import math, functools
import jax, jax.numpy as jnp
from jax import lax
import numpy as np

D_MODEL = 1024
BATCH = 2
SEQ = 8192
DEPTH = 2

HEAD_DIM = 64
N_MIX_HEADS = D_MODEL // HEAD_DIM
HEADS_PER_MIXER = N_MIX_HEADS // 4
GROUP_WIDTH = HEADS_PER_MIXER * HEAD_DIM
Q_BLOCK = 128
MOBA_BLOCK = 256
MOBA_TOPK = 3
MLA_Q_RANK = D_MODEL // 4
MLA_KV_RANK = D_MODEL // 8
MLA_NOPE = HEAD_DIM
MLA_ROPE = HEAD_DIM // 2
MLA_V = HEAD_DIM
ROPE_THETA = 10000.0
DILATED_BRANCHES = ((128, 1), (512, 4), (2048, 16))
SWA_WINDOW = 128
SWA_KV_HEADS = 2
SWA_KV_WIDTH = SWA_KV_HEADS * HEAD_DIM
D_FF = 4 * D_MODEL
EPS = 1e-6
NEG = -1e30
COL_WIDTHS = (GROUP_WIDTH, GROUP_WIDTH, GROUP_WIDTH,
              MLA_Q_RANK, MLA_KV_RANK, MLA_ROPE,
              GROUP_WIDTH, GROUP_WIDTH, GROUP_WIDTH,
              GROUP_WIDTH, SWA_KV_WIDTH, SWA_KV_WIDTH)
IN_COLS = sum(COL_WIDTHS)

kernel_name = "hybrid_parallel_moba_mla_dilated_swa"


def rms_norm(x, g):
    xf = x.astype(jnp.float32)
    y = xf * lax.rsqrt(jnp.mean(xf * xf, axis=-1, keepdims=True) + EPS)
    return (y * g.astype(jnp.float32)).astype(x.dtype)


def split_columns(h):
    parts, off = [], 0
    for wdt in COL_WIDTHS:
        parts.append(h[..., off:off + wdt])
        off += wdt
    return parts


def alibi_slopes():
    n = 3 * HEADS_PER_MIXER
    idx = np.arange(1, n + 1, dtype=np.float32).reshape(HEADS_PER_MIXER, 3)
    s = jnp.asarray(np.exp2(-8.0 * idx / n), dtype=jnp.float32)
    return s[:, 0], s[:, 1], s[:, 2]


def rope_tables(S):
    inv = 1.0 / (ROPE_THETA ** (jnp.arange(0, MLA_ROPE, 2, dtype=jnp.float32) / MLA_ROPE))
    ang = jnp.arange(S, dtype=jnp.float32)[:, None] * inv[None, :]
    return jnp.cos(ang), jnp.sin(ang)


def apply_rope(x, cos, sin):
    x1, x2 = jnp.split(x.astype(jnp.float32), 2, axis=-1)
    c, s = cos[None, :, None, :], sin[None, :, None, :]
    return jnp.concatenate([x1 * c - x2 * s, x1 * s + x2 * c], axis=-1).astype(x.dtype)


def moba_attention(q, k, v, slopes):
    B, H, S, dh = q.shape
    nb = -(-S // MOBA_BLOCK)
    Sp = nb * MOBA_BLOCK
    topk = min(MOBA_TOPK, nb)
    pad = ((0, 0), (0, 0), (0, Sp - S), (0, 0))
    qp, kp, vp = jnp.pad(q, pad), jnp.pad(k, pad), jnp.pad(v, pad)
    kb = kp.reshape(B, H, nb, MOBA_BLOCK, dh)
    vb = vp.reshape(B, H, nb, MOBA_BLOCK, dh)
    kmean = jnp.mean(kb.astype(jnp.float32), axis=3)
    scale = dh ** -0.5
    bi = jnp.arange(B)[:, None, None, None]
    hi = jnp.arange(H)[None, :, None, None]
    slope_b = slopes.astype(jnp.float32)

    def chunk(c):
        t0 = c * Q_BLOCK
        qc = lax.dynamic_slice_in_dim(qp, t0, Q_BLOCK, axis=2)
        tpos = t0 + jnp.arange(Q_BLOCK)
        qblk = tpos // MOBA_BLOCK
        own = t0 // MOBA_BLOCK
        gate = jnp.einsum('bhqd,bhnd->bhqn', qc.astype(jnp.float32), kmean)
        past = jnp.arange(nb)[None, :] < qblk[:, None]
        gate = jnp.where(past, gate, NEG)
        _, sel = lax.top_k(gate, topk)
        sel_ok = sel < qblk[:, None]
        ksel = kb[bi, hi, sel]
        vsel = vb[bi, hi, sel]
        kpos_sel = sel[..., None] * MOBA_BLOCK + jnp.arange(MOBA_BLOCK)
        dist_sel = (tpos[:, None, None] - kpos_sel).astype(jnp.float32)
        s_sel = (jnp.einsum('bhqd,bhqjkd->bhqjk', qc, ksel).astype(jnp.float32) * scale
                 - slope_b[None, :, None, None, None] * dist_sel)
        s_sel = jnp.where(sel_ok[..., None], s_sel, NEG).reshape(B, H, Q_BLOCK, topk * MOBA_BLOCK)
        kown = lax.dynamic_slice_in_dim(kb, own, 1, axis=2)[:, :, 0]
        vown = lax.dynamic_slice_in_dim(vb, own, 1, axis=2)[:, :, 0]
        dist_own = tpos[:, None] - (own * MOBA_BLOCK + jnp.arange(MOBA_BLOCK))[None, :]
        s_own = (jnp.einsum('bhqd,bhkd->bhqk', qc, kown).astype(jnp.float32) * scale
                 - slope_b[None, :, None, None] * dist_own.astype(jnp.float32))
        s_own = jnp.where(dist_own >= 0, s_own, NEG)
        p = jax.nn.softmax(jnp.concatenate([s_sel, s_own], axis=-1), axis=-1)
        p_sel = p[..., :topk * MOBA_BLOCK].reshape(B, H, Q_BLOCK, topk, MOBA_BLOCK)
        p_own = p[..., topk * MOBA_BLOCK:]
        return (jnp.einsum('bhqjk,bhqjkd->bhqd', p_sel.astype(v.dtype), vsel)
                + jnp.einsum('bhqk,bhkd->bhqd', p_own.astype(v.dtype), vown))

    out = lax.map(chunk, jnp.arange(Sp // Q_BLOCK))
    return out.transpose(1, 2, 0, 3, 4).reshape(B, H, Sp, dh)[:, :, :S]


def causal_dense_attention(q, k, v, scale):
    B, H, S, _ = q.shape
    kpos = jnp.arange(S)

    def blk(c):
        qc = lax.dynamic_slice_in_dim(q, c * Q_BLOCK, Q_BLOCK, axis=2)
        s = jnp.einsum('bhqd,bhkd->bhqk', qc, k).astype(jnp.float32) * scale
        tpos = c * Q_BLOCK + jnp.arange(Q_BLOCK)
        s = jnp.where(kpos[None, :] <= tpos[:, None], s, NEG)
        p = jax.nn.softmax(s, axis=-1)
        return jnp.einsum('bhqk,bhkd->bhqd', p.astype(v.dtype), v)

    out = lax.map(blk, jnp.arange(S // Q_BLOCK))
    return out.transpose(1, 2, 0, 3, 4).reshape(B, H, S, -1)


def mla_attention(q_lat, kv_lat, k_rope, g_qlat, g_kvlat, w_uq, w_ukv, g_q, g_k):
    B, S, _ = q_lat.shape
    H = HEADS_PER_MIXER
    qk_dim = MLA_NOPE + MLA_ROPE
    q = (rms_norm(q_lat, g_qlat) @ w_uq).reshape(B, S, H, qk_dim)
    kv = (rms_norm(kv_lat, g_kvlat) @ w_ukv).reshape(B, S, H, MLA_NOPE + MLA_V)
    k_nope, v = kv[..., :MLA_NOPE], kv[..., MLA_NOPE:]
    k = jnp.concatenate([k_nope, jnp.broadcast_to(k_rope[:, :, None, :], (B, S, H, MLA_ROPE))], axis=-1)
    q, k = rms_norm(q, g_q), rms_norm(k, g_k)
    cos, sin = rope_tables(S)
    q = jnp.concatenate([q[..., :MLA_NOPE], apply_rope(q[..., MLA_NOPE:], cos, sin)], axis=-1)
    k = jnp.concatenate([k[..., :MLA_NOPE], apply_rope(k[..., MLA_NOPE:], cos, sin)], axis=-1)
    t = lambda a: a.transpose(0, 2, 1, 3)
    return causal_dense_attention(t(q), t(k), t(v), qk_dim ** -0.5)


def dilated_branch(q, k, v, slopes, window, dilation):
    B, H, S, dh = q.shape
    span = dilation * Q_BLOCK
    Sp = -(-S // span) * span
    L = Sp // dilation
    nb = L // Q_BLOCK
    steps = window // dilation

    def to_sub(t):
        t = jnp.pad(t, ((0, 0), (0, 0), (0, Sp - S), (0, 0)))
        return t.reshape(B, H, L, dilation, dh).transpose(0, 1, 3, 2, 4).reshape(B, H, dilation, nb, Q_BLOCK, dh)

    def with_prev(t):
        prev = jnp.pad(t, ((0, 0), (0, 0), (0, 0), (1, 0), (0, 0), (0, 0)))[:, :, :, :-1]
        return jnp.concatenate([prev, t], axis=4)

    qs = to_sub(q)
    kk, vv = with_prev(to_sub(k)), with_prev(to_sub(v))
    qi = jnp.arange(Q_BLOCK)[:, None]
    kidx = jnp.arange(2 * Q_BLOCK)[None, :]
    rel = qi + Q_BLOCK - kidx
    blk = jnp.arange(nb)[:, None, None]
    valid = (rel >= 0) & (rel <= steps) & (blk * Q_BLOCK + kidx[None] - Q_BLOCK >= 0)
    s = (jnp.einsum('bhrnqd,bhrnkd->bhrnqk', qs, kk).astype(jnp.float32) * (dh ** -0.5)
         - slopes.astype(jnp.float32)[None, :, None, None, None, None] * (dilation * rel).astype(jnp.float32))
    s = jnp.where(valid, s, NEG)
    m = jnp.max(s, axis=-1, keepdims=True)
    e = jnp.exp(s - m)
    l = jnp.sum(e, axis=-1, keepdims=True)
    o = jnp.einsum('bhrnqk,bhrnkd->bhrnqd', e, vv.astype(jnp.float32))
    back = lambda t: t.reshape(B, H, dilation, L, -1).transpose(0, 1, 3, 2, 4).reshape(B, H, Sp, -1)[:, :, :S]
    return back(o), back(m), back(l)


def dilated_mixture(q, k, v, slopes):
    branches = [dilated_branch(q, k, v, slopes, w, d) for (w, d) in DILATED_BRANCHES]
    M = functools.reduce(jnp.maximum, [b[1] for b in branches])
    num = jnp.zeros(q.shape, jnp.float32)
    den = jnp.zeros(q.shape[:-1] + (1,), jnp.float32)
    for o, m, l in branches:
        w = jnp.exp(m - M)
        num = num + w * o
        den = den + w * l
    return (num / den).astype(q.dtype)


def swa_sink_attention(q, k, v, sinks, slopes):
    B, H, S, dh = q.shape
    G = H // SWA_KV_HEADS
    nb = S // Q_BLOCK
    qb = q.reshape(B, SWA_KV_HEADS, G, nb, Q_BLOCK, dh)

    def with_prev(t):
        t = t.reshape(B, SWA_KV_HEADS, nb, Q_BLOCK, dh)
        prev = jnp.pad(t, ((0, 0), (0, 0), (1, 0), (0, 0), (0, 0)))[:, :, :-1]
        return jnp.concatenate([prev, t], axis=3)

    kk, vv = with_prev(k), with_prev(v)
    qi = jnp.arange(Q_BLOCK)[:, None]
    kidx = jnp.arange(2 * Q_BLOCK)[None, :]
    rel = qi + Q_BLOCK - kidx
    blk = jnp.arange(nb)[:, None, None]
    valid = (rel >= 0) & (rel < SWA_WINDOW) & (blk * Q_BLOCK + kidx[None] - Q_BLOCK >= 0)
    sl = slopes.astype(jnp.float32).reshape(SWA_KV_HEADS, G)[None, :, :, None, None, None]
    s = jnp.einsum('bkgnqd,bkncd->bkgnqc', qb, kk).astype(jnp.float32) * (dh ** -0.5) - sl * rel.astype(jnp.float32)
    s = jnp.where(valid, s, NEG)
    sink = jnp.broadcast_to(sinks.astype(jnp.float32).reshape(SWA_KV_HEADS, G)[None, :, :, None, None, None],
                            s.shape[:-1] + (1,))
    p = jax.nn.softmax(jnp.concatenate([s, sink], axis=-1), axis=-1)[..., :-1]
    o = jnp.einsum('bkgnqc,bkncd->bkgnqd', p.astype(v.dtype), vv)
    return o.reshape(B, H, S, dh)


def hybrid_layer(x, attn_norm_g, w_in, moba_q_g, moba_k_g, mla_qlat_g, mla_kvlat_g,
                 mla_w_uq, mla_w_ukv, mla_q_g, mla_k_g, dil_q_g, dil_k_g, swa_q_g, swa_k_g,
                 swa_sinks, group_out_g, w_o, mlp_norm_g, w_up, w_down):
    B, S, _ = x.shape
    H = HEADS_PER_MIXER
    slope_a, slope_c, slope_d = alibi_slopes()
    h = rms_norm(x, attn_norm_g) @ w_in
    a_q, a_k, a_v, b_ql, b_kvl, b_kr, c_q, c_k, c_v, d_q, d_k, d_v = split_columns(h)
    heads = lambda t, n: t.reshape(B, S, n, HEAD_DIM)
    tr = lambda t: t.transpose(0, 2, 1, 3)
    oa = moba_attention(tr(rms_norm(heads(a_q, H), moba_q_g)), tr(rms_norm(heads(a_k, H), moba_k_g)),
                        tr(heads(a_v, H)), slope_a)
    ob = mla_attention(b_ql, b_kvl, b_kr, mla_qlat_g, mla_kvlat_g, mla_w_uq, mla_w_ukv, mla_q_g, mla_k_g)
    oc = dilated_mixture(tr(rms_norm(heads(c_q, H), dil_q_g)), tr(rms_norm(heads(c_k, H), dil_k_g)),
                         tr(heads(c_v, H)), slope_c)
    od = swa_sink_attention(tr(rms_norm(heads(d_q, H), swa_q_g)),
                            tr(rms_norm(heads(d_k, SWA_KV_HEADS), swa_k_g)),
                            tr(heads(d_v, SWA_KV_HEADS)), swa_sinks, slope_d)
    groups = [tr(o).reshape(B, S, GROUP_WIDTH) for o in (oa, ob, oc, od)]
    mixed = jnp.concatenate([rms_norm(gr, group_out_g[i]) for i, gr in enumerate(groups)], axis=-1)
    x = x + mixed @ w_o
    u = jax.nn.relu(rms_norm(x, mlp_norm_g) @ w_up)
    return x + (u * u) @ w_down


def setup_inputs(seed: int = 0) -> dict:
    key = jax.random.key(seed)
    ks = jax.random.split(key, 24)
    f = jnp.float32
    H = HEADS_PER_MIXER
    w = lambda k, shape, fan_in: jax.random.normal(k, shape, f) * (fan_in ** -0.5)
    g = lambda k, shape: 1.0 + 0.02 * jax.random.normal(k, shape, f)
    return {
        "x": jax.random.normal(ks[0], (BATCH, SEQ, D_MODEL), f),
        "attn_norm_g": g(ks[1], (DEPTH, D_MODEL)),
        "w_in": w(ks[2], (DEPTH, D_MODEL, IN_COLS), D_MODEL),
        "moba_q_g": g(ks[3], (DEPTH, HEAD_DIM)),
        "moba_k_g": g(ks[4], (DEPTH, HEAD_DIM)),
        "mla_qlat_g": g(ks[5], (DEPTH, MLA_Q_RANK)),
        "mla_kvlat_g": g(ks[6], (DEPTH, MLA_KV_RANK)),
        "mla_w_uq": w(ks[7], (DEPTH, MLA_Q_RANK, H * (MLA_NOPE + MLA_ROPE)), MLA_Q_RANK),
        "mla_w_ukv": w(ks[8], (DEPTH, MLA_KV_RANK, H * (MLA_NOPE + MLA_V)), MLA_KV_RANK),
        "mla_q_g": g(ks[9], (DEPTH, MLA_NOPE + MLA_ROPE)),
        "mla_k_g": g(ks[10], (DEPTH, MLA_NOPE + MLA_ROPE)),
        "dil_q_g": g(ks[11], (DEPTH, HEAD_DIM)),
        "dil_k_g": g(ks[12], (DEPTH, HEAD_DIM)),
        "swa_q_g": g(ks[13], (DEPTH, HEAD_DIM)),
        "swa_k_g": g(ks[14], (DEPTH, HEAD_DIM)),
        "swa_sinks": 0.5 * jax.random.normal(ks[15], (DEPTH, H), f),
        "group_out_g": g(ks[16], (DEPTH, 4, GROUP_WIDTH)),
        "w_o": w(ks[17], (DEPTH, D_MODEL, D_MODEL), D_MODEL),
        "mlp_norm_g": g(ks[18], (DEPTH, D_MODEL)),
        "w_up": w(ks[19], (DEPTH, D_MODEL, D_FF), D_MODEL),
        "w_down": w(ks[20], (DEPTH, D_FF, D_MODEL), D_FF),
    }


def reference(x, attn_norm_g, w_in, moba_q_g, moba_k_g, mla_qlat_g, mla_kvlat_g, mla_w_uq,
              mla_w_ukv, mla_q_g, mla_k_g, dil_q_g, dil_k_g, swa_q_g, swa_k_g, swa_sinks,
              group_out_g, w_o, mlp_norm_g, w_up, w_down):
    for l in range(DEPTH):
        x = hybrid_layer(x, attn_norm_g[l], w_in[l], moba_q_g[l], moba_k_g[l], mla_qlat_g[l],
                         mla_kvlat_g[l], mla_w_uq[l], mla_w_ukv[l], mla_q_g[l], mla_k_g[l],
                         dil_q_g[l], dil_k_g[l], swa_q_g[l], swa_k_g[l], swa_sinks[l],
                         group_out_g[l], w_o[l], mlp_norm_g[l], w_up[l], w_down[l])
    return x
```

```cpp
#include <hip/hip_runtime.h>
#include <cstdio>
#include <cstdint>
#include <cmath>

#define LAS __attribute__((address_space(3)))
#define GAS __attribute__((address_space(1)))
typedef _Float16 f16;
typedef _Float16 h8 __attribute__((ext_vector_type(8)));
typedef _Float16 h4 __attribute__((ext_vector_type(4)));
typedef _Float16 h2 __attribute__((ext_vector_type(2)));
typedef float f32x4 __attribute__((ext_vector_type(4)));
typedef float f32x2 __attribute__((ext_vector_type(2)));
typedef unsigned u32x4 __attribute__((ext_vector_type(4)));
typedef unsigned u32x2 __attribute__((ext_vector_type(2)));

constexpr int BATCH = 2, SEQ = 8192, DM = 1024, T = BATCH * SEQ, DEPTH = 2;
constexpr int NIN = 2464, HBP = 2560, DFF = 4096;
constexpr float EPS = 1e-6f;
constexpr float LOG2E = 1.4426950408889634f;
constexpr float C2_64 = 0.125f * LOG2E;
constexpr float C2_96 = 0.10206207261596577f * LOG2E;
constexpr int C_AQ = 0, C_AK = 256, C_AV = 512, C_QL = 768, C_KVL = 1024, C_KR = 1152, C_CQ = 1280, C_CK = 1536, C_CV = 1792, C_DQ = 2048, C_DK = 2304, C_DV = 2432;

constexpr size_t MiB = 1u << 20;
constexpr size_t WS_CTL = 0;
constexpr size_t WS_W = 1 * MiB, W_LAYER = 24 * MiB;
constexpr size_t WO_IN = 0, WO_O = 5 * MiB, WO_UP = 7 * MiB, WO_DOWN = 15 * MiB, WO_UQ = 23 * MiB, WO_UKV = 23 * MiB + 256 * 1024, WO_GT = 23 * MiB + 512 * 1024;
constexpr size_t WS_ROPE = 49 * MiB;
constexpr size_t WS_XN = 50 * MiB;
constexpr size_t WS_CPO = 50 * MiB;
constexpr size_t WS_HB = 82 * MiB;
constexpr size_t WS_QB = 162 * MiB, WS_KB = 174 * MiB, WS_VB = 186 * MiB;
constexpr size_t WS_QLN = 194 * MiB, WS_KVN = 202 * MiB;
constexpr size_t WS_KMP = 242 * MiB;
constexpr size_t WS_CPML = 243 * MiB;
constexpr size_t WS_H = 82 * MiB;
constexpr size_t WS_OR = 210 * MiB;
constexpr size_t WS_QU = 210 * MiB, WS_KVU = 226 * MiB;
constexpr size_t WS_END = 256 * MiB;

namespace pg8 {
constexpr int BM = 256, BK = 64, HALF = 128, HTB = HALF * BK * 2, STAGE_BYTES = 8 * HTB, NXCD = 8, WGM = 8;
__host__ __device__ __forceinline__ int lds_byte(int r, int c) { const int st = (r >> 4) * 2 + (c >> 5), rr = r & 15, cc = c & 31, ob = rr * 64 + cc * 2; return st * 1024 + (ob ^ (((ob >> 9) & 1) << 5)); }
__host__ __device__ __forceinline__ void stage_rc(int b, int& R, int& C) { const int st = b / 1024, sb = b % 1024, swz = sb ^ (((sb >> 9) & 1) << 5); R = (st >> 1) * 16 + swz / 64; C = (st & 1) * 32 + (swz % 64) / 2; }
__host__ __device__ __forceinline__ int perm32(int rho) { const int n = rho >> 4, i = rho & 15; return 8 * (i >> 2) + 4 * n + (i & 3); }
struct Unit { int pm, pn; };
struct Gemm { const f16* A; const f16* Bt; int M, N, K, lda; };
struct StaticOrder {
    int nM, nN, nwg, G, c;
    __device__ void init(int M, int N, int G_, int c_) { nM = M / BM; nN = N / BM; nwg = nM * nN; G = G_; c = c_; }
    __device__ bool next(int i, Unit& u) const {
        const long L = (long)i * G + c; if (L >= nwg) return false;
        int wgid = (int)L; { const int q = nwg / NXCD, r = nwg % NXCD, xcd = wgid % NXCD, off = wgid / NXCD; wgid = (xcd < r ? xcd * (q + 1) : r * (q + 1) + (xcd - r) * q) + off; }
        const int nig = WGM * nN, gid = wgid / nig, fm = gid * WGM, gsz = (nM - fm) < WGM ? (nM - fm) : WGM;
        u.pm = fm + ((wgid % nig) % gsz); u.pn = (wgid % nig) / gsz; return true;
    }
};
__device__ __forceinline__ u32x4 pack8(f32x4 a, f32x4 b) {
    u32x4 w;
    w.x = __builtin_bit_cast(unsigned, __builtin_convertvector((f32x2){a[0], a[1]}, h2));
    w.y = __builtin_bit_cast(unsigned, __builtin_convertvector((f32x2){a[2], a[3]}, h2));
    w.z = __builtin_bit_cast(unsigned, __builtin_convertvector((f32x2){b[0], b[1]}, h2));
    w.w = __builtin_bit_cast(unsigned, __builtin_convertvector((f32x2){b[2], b[3]}, h2));
    return w;
}
template <int ACT> struct EpiF16 {
    static constexpr bool PERM = true;
    f16* O; int ldc;
    __device__ __forceinline__ void operator()(const f32x4 (&acc)[2][2][4][2], const Unit& u, int wr, int wc) const {
        int lane_ = threadIdx.x & 63; asm volatile("" : "+v"(lane_)); const int fr = lane_ & 15, fq = lane_ >> 4;
        const int row0 = u.pm * BM + wr * 64 + fr, col0 = u.pn * BM + wc * 32 + 8 * fq;
#pragma unroll
        for (int ai = 0; ai < 2; ++ai)
#pragma unroll
            for (int m = 0; m < 4; ++m) { f16* rowp = O + (size_t)(row0 + ai * HALF + m * 16) * ldc + col0;
#pragma unroll
                for (int bj = 0; bj < 2; ++bj) { f32x4 v0 = acc[ai][bj][m][0], v1 = acc[ai][bj][m][1];
                    if (ACT == 1) {
#pragma unroll
                        for (int e = 0; e < 4; ++e) { const float a = fmaxf(v0[e], 0.f), b = fmaxf(v1[e], 0.f); v0[e] = a * a; v1[e] = b * b; } }
                    *(u32x4*)(rowp + bj * HALF) = pack8(v0, v1); } }
    }
};
struct EpiRes {
    static constexpr bool PERM = false;
    const float* base; float* out; int ldc;
    __device__ __forceinline__ void operator()(const f32x4 (&acc)[2][2][4][2], const Unit& u, int wr, int wc) const {
        int lane_ = threadIdx.x & 63; asm volatile("" : "+v"(lane_)); const int fr = lane_ & 15, fq = lane_ >> 4;
        const int row0 = u.pm * BM + wr * 64 + fr, col0 = u.pn * BM + wc * 32 + 4 * fq;
#pragma unroll
        for (int ai = 0; ai < 2; ++ai)
#pragma unroll
            for (int m = 0; m < 4; ++m) { const size_t off = (size_t)(row0 + ai * HALF + m * 16) * ldc + col0;
#pragma unroll
                for (int bj = 0; bj < 2; ++bj)
#pragma unroll
                    for (int n = 0; n < 2; ++n) { const f32x4 b = *(const f32x4*)(base + off + bj * HALF + n * 16); *(f32x4*)(out + off + bj * HALF + n * 16) = b + acc[ai][bj][m][n]; } }
    }
};
struct EpiIn {
    static constexpr bool PERM = true;
    f16* HB; const float* GT;
    __device__ __forceinline__ void operator()(const f32x4 (&acc)[2][2][4][2], const Unit& u, int wr, int wc) const {
        int lane_ = threadIdx.x & 63; asm volatile("" : "+v"(lane_)); const int fr = lane_ & 15, fq = lane_ >> 4;
        const int pn = u.pn;
        const bool normed = (pn == 0) | (pn == 1) | (pn == 5) | (pn == 6) | (pn == 8) | ((pn == 9) & (wc < 2));
        const float* g = normed ? GT + (pn * 4 + wc) * 64 : nullptr;
        const int row0 = u.pm * BM + wr * 64 + fr, col0 = pn * BM + wc * 64 + 8 * fq;
        asm volatile("" : "+s"(g));
        if (g) {
            float rs[2][4];
#pragma unroll
            for (int ai = 0; ai < 2; ++ai)
#pragma unroll
                for (int m = 0; m < 4; ++m) {
                    float ss = 0.f;
#pragma unroll
                    for (int bj = 0; bj < 2; ++bj)
#pragma unroll
                        for (int n = 0; n < 2; ++n) { const f32x4 x = acc[ai][bj][m][n]; ss += (x[0] * x[0] + x[1] * x[1]) + (x[2] * x[2] + x[3] * x[3]); }
                    ss += __shfl_xor(ss, 16); ss += __shfl_xor(ss, 32);
                    rs[ai][m] = __builtin_amdgcn_rsqf(ss * (1.0f / 64.0f) + EPS);
                }
#pragma unroll
            for (int bj = 0; bj < 2; ++bj) {
                const f32x4 g0 = *(const f32x4*)(g + 32 * bj + 8 * fq), g1 = *(const f32x4*)(g + 32 * bj + 8 * fq + 4);
#pragma unroll
                for (int ai = 0; ai < 2; ++ai)
#pragma unroll
                    for (int m = 0; m < 4; ++m) { const f32x4 v0 = acc[ai][bj][m][0] * rs[ai][m] * g0, v1 = acc[ai][bj][m][1] * rs[ai][m] * g1;
                        *(u32x4*)(HB + (size_t)(row0 + ai * HALF + m * 16) * HBP + col0 + bj * 32) = pack8(v0, v1);
                        if (m & 1) asm volatile("" ::: "memory"); }
            }
        } else {
#pragma unroll
            for (int ai = 0; ai < 2; ++ai)
#pragma unroll
                for (int m = 0; m < 4; ++m) { f16* rowp = HB + (size_t)(row0 + ai * HALF + m * 16) * HBP + col0;
#pragma unroll
                    for (int bj = 0; bj < 2; ++bj) *(u32x4*)(rowp + bj * 32) = pack8(acc[ai][bj][m][0], acc[ai][bj][m][1]); }
        }
    }
};

template <class Epi, bool ALIGN_EPI, bool SP2>
__device__ __forceinline__ void gemm_phase(LAS unsigned char* lds, const Gemm g, const StaticOrder& S, const Epi& E) {
    int tid_ = threadIdx.x; asm volatile("" : "+v"(tid_));
    const int tid = tid_, wid = __builtin_amdgcn_readfirstlane(tid >> 6), lane = tid & 63, wr = wid >> 2, wc = wid & 3, fr = lane & 15, fq = lane >> 4;
    const int K = g.K, nt = K / BK, lda = g.lda;
    unsigned voffA[2], voffB[2];
#pragma unroll
    for (int i = 0; i < 2; ++i) { int R, C; stage_rc(tid * 16 + i * 8192, R, C); const int Rb = Epi::PERM ? ((R & ~31) + perm32(R & 31)) : R;
        voffA[i] = (unsigned)(R * lda + C) * 2u; voffB[i] = (unsigned)(Rb * K + C) * 2u; }
    const size_t kstep = (size_t)(BK * 2);
    const size_t hstepA = (size_t)HALF * lda * 2, hstepB = (size_t)HALF * K * 2;
    const size_t tstepA = 2 * hstepA, tstepB = 2 * hstepB;
    const unsigned ldsw = (unsigned)wid * 1024u;
    const int aoff = lds_byte(wr * 64 + fr, fq * 8), boff = lds_byte(wc * 32 + fr, fq * 8);
#define PG8_SA(b, h) (((b) * 2 + (h)) * HTB)
#define PG8_SB(b, h) ((4 + (b) * 2 + (h)) * HTB)
#define PG8_STAGE(bufoff, gbase, voff) do { _Pragma("unroll") for (int _i = 0; _i < 2; ++_i) \
        __builtin_amdgcn_global_load_lds((const unsigned*)((const char*)(gbase) + (voff)[_i]), (LAS unsigned*)(lds + (bufoff) + ldsw + _i * 8192), 16, 0, 0); } while (0)
#define PG8_LDA(dst, b, h) do { _Pragma("unroll") for (int m = 0; m < 4; ++m) _Pragma("unroll") for (int k = 0; k < 2; ++k) dst[m][k] = *(const LAS h8*)(lds + PG8_SA(b, h) + aoff + m * 2048 + k * 1024); } while (0)
#define PG8_LDB(dst, b, h) do { _Pragma("unroll") for (int n = 0; n < 2; ++n) _Pragma("unroll") for (int k = 0; k < 2; ++k) dst[n][k] = *(const LAS h8*)(lds + PG8_SB(b, h) + boff + n * 2048 + k * 1024); } while (0)
#define PG8_MMA(ai, bj, At, Bt) do { __builtin_amdgcn_s_setprio(1); _Pragma("unroll") for (int m = 0; m < 4; ++m) _Pragma("unroll") for (int n = 0; n < 2; ++n) _Pragma("unroll") for (int k = 0; k < 2; ++k) \
        acc[ai][bj][m][n] = __builtin_amdgcn_mfma_f32_16x16x32_f16(Bt[n][k], At[m][k], acc[ai][bj][m][n], 0, 0, 0); __builtin_amdgcn_s_setprio(0); } while (0)
#define PG8_WAIT_V(n) asm volatile("s_waitcnt vmcnt(" #n ")" ::: "memory")
#define PG8_WAIT_L(n) asm volatile("s_waitcnt lgkmcnt(" #n ")" ::: "memory")
#define PG8_BAR __builtin_amdgcn_s_barrier()
#define PG8_SCHED __builtin_amdgcn_sched_barrier(0)
    Unit cur, nxt; int ui = 0;
    if (!S.next(0, cur)) return;
    f32x4 acc[2][2][4][2];
#pragma unroll
    for (int a = 0; a < 2; ++a)
#pragma unroll
        for (int b = 0; b < 2; ++b)
#pragma unroll
            for (int m = 0; m < 4; ++m)
#pragma unroll
                for (int n = 0; n < 2; ++n) acc[a][b][m][n] = (f32x4){0.f, 0.f, 0.f, 0.f};
    h8 At[4][2], B0[2][2], B1[2][2];
    const char* cA = (const char*)g.A + (size_t)cur.pm * tstepA; const char* cB = (const char*)g.Bt + (size_t)cur.pn * tstepB;
    if constexpr (SP2) {
        PG8_STAGE(PG8_SB(0, 0), cB, voffB); PG8_STAGE(PG8_SB(0, 1), cB + hstepB, voffB); PG8_STAGE(PG8_SA(0, 0), cA, voffA); PG8_STAGE(PG8_SA(0, 1), cA + hstepA, voffA);
        if (wr == 1) PG8_BAR;
        PG8_WAIT_V(2); PG8_BAR;
        PG8_STAGE(PG8_SB(1, 0), cB + kstep, voffB); PG8_STAGE(PG8_SA(1, 0), cA + kstep, voffA); PG8_STAGE(PG8_SB(1, 1), cB + hstepB + kstep, voffB);
        PG8_WAIT_V(6); PG8_BAR;
    } else {
        PG8_STAGE(PG8_SB(0, 0), cB, voffB); PG8_STAGE(PG8_SA(0, 0), cA, voffA); PG8_STAGE(PG8_SB(0, 1), cB + hstepB, voffB); PG8_STAGE(PG8_SA(0, 1), cA + hstepA, voffA);
        if (wr == 1) PG8_BAR;
        PG8_WAIT_V(4); PG8_BAR;
        PG8_STAGE(PG8_SB(1, 0), cB + kstep, voffB); PG8_STAGE(PG8_SA(1, 0), cA + kstep, voffA); PG8_STAGE(PG8_SB(1, 1), cB + hstepB + kstep, voffB);
        PG8_WAIT_V(6); PG8_BAR;
    }
    for (;;) {
        const bool has_next = S.next(ui + 1, nxt);
        const char* nA = has_next ? (const char*)g.A + (size_t)nxt.pm * tstepA : cA; const char* nB = has_next ? (const char*)g.Bt + (size_t)nxt.pn * tstepB : cB;
#pragma nounroll
        for (int t = 0; t < nt; t += 2) {
            const bool last = (t == nt - 2);
            const char* a1 = cA + (size_t)(t + 1) * kstep;
            const char* a2 = last ? nA : cA + (size_t)(t + 2) * kstep; const char* b2 = last ? nB : cB + (size_t)(t + 2) * kstep;
            const char* a3 = a2 + kstep; const char* b3 = b2 + kstep;
            if constexpr (SP2) {
            PG8_LDB(B0, 0, 0); PG8_LDB(B1, 0, 1); PG8_SCHED; PG8_LDA(At, 0, 0); PG8_STAGE(PG8_SA(1, 1), a1 + hstepA, voffA);
            PG8_WAIT_V(8); PG8_WAIT_L(0); PG8_BAR; PG8_MMA(0, 0, At, B0); PG8_MMA(0, 1, At, B1); PG8_BAR; PG8_SCHED;
            PG8_LDA(At, 0, 1); PG8_STAGE(PG8_SB(0, 0), b2, voffB); PG8_STAGE(PG8_SB(0, 1), b2 + hstepB, voffB); PG8_STAGE(PG8_SA(0, 0), a2, voffA);
            PG8_WAIT_V(8); PG8_WAIT_L(0); PG8_BAR; PG8_MMA(1, 0, At, B0); PG8_MMA(1, 1, At, B1); PG8_BAR; PG8_SCHED;
            PG8_LDB(B0, 1, 0); PG8_LDB(B1, 1, 1); PG8_SCHED; PG8_LDA(At, 1, 0); PG8_STAGE(PG8_SA(0, 1), a2 + hstepA, voffA);
            PG8_WAIT_V(8); PG8_WAIT_L(0); PG8_BAR; PG8_MMA(0, 0, At, B0); PG8_MMA(0, 1, At, B1); PG8_BAR; PG8_SCHED;
            PG8_LDA(At, 1, 1); PG8_STAGE(PG8_SB(1, 0), b3, voffB); PG8_STAGE(PG8_SB(1, 1), b3 + hstepB, voffB); PG8_STAGE(PG8_SA(1, 0), a3, voffA);
            PG8_WAIT_V(8); PG8_WAIT_L(0); PG8_BAR; PG8_MMA(1, 0, At, B0); PG8_MMA(1, 1, At, B1); PG8_BAR; PG8_SCHED;
            } else {
            PG8_LDB(B0, 0, 0); PG8_SCHED; PG8_LDA(At, 0, 0); PG8_STAGE(PG8_SA(1, 1), a1 + hstepA, voffA);
            PG8_WAIT_L(8); PG8_BAR; PG8_WAIT_L(0); PG8_MMA(0, 0, At, B0); PG8_BAR; PG8_SCHED;
            PG8_LDB(B1, 0, 1); PG8_STAGE(PG8_SB(0, 0), b2, voffB);
            PG8_BAR; PG8_WAIT_L(0); PG8_MMA(0, 1, At, B1); PG8_BAR;
            PG8_LDA(At, 0, 1); PG8_STAGE(PG8_SA(0, 0), a2, voffA);
            PG8_BAR; PG8_WAIT_L(0); PG8_MMA(1, 0, At, B0); PG8_BAR; PG8_SCHED;
            PG8_STAGE(PG8_SB(0, 1), b2 + hstepB, voffB);
            PG8_WAIT_V(6); PG8_BAR; PG8_MMA(1, 1, At, B1); PG8_BAR;
            PG8_LDB(B0, 1, 0); PG8_SCHED; PG8_LDA(At, 1, 0); PG8_STAGE(PG8_SA(0, 1), a2 + hstepA, voffA);
            PG8_WAIT_L(8); PG8_BAR; PG8_WAIT_L(0); PG8_MMA(0, 0, At, B0); PG8_BAR; PG8_SCHED;
            PG8_LDB(B1, 1, 1); PG8_STAGE(PG8_SB(1, 0), b3, voffB);
            PG8_BAR; PG8_WAIT_L(0); PG8_MMA(0, 1, At, B1); PG8_BAR;
            PG8_LDA(At, 1, 1); PG8_STAGE(PG8_SA(1, 0), a3, voffA);
            PG8_BAR; PG8_WAIT_L(0); PG8_MMA(1, 0, At, B0); PG8_BAR; PG8_SCHED;
            PG8_STAGE(PG8_SB(1, 1), b3 + hstepB, voffB);
            PG8_WAIT_V(6); PG8_BAR; PG8_MMA(1, 1, At, B1); PG8_BAR;
            }
        }
        if constexpr (ALIGN_EPI) { if (wr == 0) PG8_BAR; }
        E(acc, cur, wr, wc);
        if (!has_next) break;
#pragma unroll
        for (int a = 0; a < 2; ++a)
#pragma unroll
            for (int b = 0; b < 2; ++b)
#pragma unroll
                for (int m = 0; m < 4; ++m)
#pragma unroll
                    for (int n = 0; n < 2; ++n) acc[a][b][m][n] = (f32x4){0.f, 0.f, 0.f, 0.f};
        cur = nxt; cA = nA; cB = nB; ++ui;
        if constexpr (ALIGN_EPI) { if (wr == 1) PG8_BAR; }
    }
    PG8_WAIT_V(0);
    if constexpr (!ALIGN_EPI) { if (wr == 0) PG8_BAR; }
    PG8_BAR;
#undef PG8_SA
#undef PG8_SB
#undef PG8_STAGE
#undef PG8_LDA
#undef PG8_LDB
#undef PG8_MMA
#undef PG8_WAIT_V
#undef PG8_WAIT_L
#undef PG8_BAR
#undef PG8_SCHED
}
}

constexpr int NWAVES = 8;
constexpr int LDS_BYTES = 147456;
#define LDS_WAIT() asm volatile("s_waitcnt lgkmcnt(0)" ::: "memory")
#define VM_WAIT() asm volatile("s_waitcnt vmcnt(0)" ::: "memory")

struct Args { const float* in[21]; float* out; unsigned char* ws; int ph_lo, ph_hi, li, pad; };
enum { I_X = 0, I_ANG, I_WIN, I_MQG, I_MKG, I_QLG, I_KVLG, I_WUQ, I_WUKV, I_BQG, I_BKG, I_CQG, I_CKG, I_DQG, I_DKG, I_SINK, I_GOG, I_WO, I_MNG, I_WUP, I_WDOWN };

struct Frame {
    LAS unsigned char* lds;
    int vcu, G;
    float* out; unsigned char* ws;
};
__device__ __forceinline__ int lane_id() { return threadIdx.x & 63; }
__device__ __forceinline__ int wave_id() { return __builtin_amdgcn_readfirstlane(threadIdx.x >> 6); }
__device__ __forceinline__ float wave_sum(float v) {
#pragma unroll
    for (int o = 1; o < 64; o <<= 1) v += __shfl_xor(v, o);
    return v;
}
__device__ __forceinline__ unsigned pk2h(float lo, float hi) { return __builtin_bit_cast(unsigned, __builtin_convertvector((f32x2){lo, hi}, h2)); }
__device__ __forceinline__ f16* wt_ptr(const Frame& F, int l, size_t off) { return (f16*)(F.ws + WS_W + (size_t)l * W_LAYER + off); }

__device__ __forceinline__ void sincos_d(double a, double& c, double& s) {
    const double k = __builtin_rint(a * 0.63661977236758134308);
    const double r = (a - k * 1.57079632679489655800) - k * 6.12323399573676603587e-17;
    const double r2 = r * r;
    const double sp = r * (1.0 + r2 * (-1.0 / 6 + r2 * (1.0 / 120 + r2 * (-1.0 / 5040 + r2 * (1.0 / 362880 + r2 * (-1.0 / 39916800 + r2 * (1.0 / 6227020800.0)))))));
    const double cp = 1.0 + r2 * (-0.5 + r2 * (1.0 / 24 + r2 * (-1.0 / 720 + r2 * (1.0 / 40320 + r2 * (-1.0 / 3628800 + r2 * (1.0 / 479001600.0))))));
    const int q = (int)((long long)k & 3);
    s = (q == 0) ? sp : (q == 1) ? cp : (q == 2) ? -sp : -cp;
    c = (q == 0) ? cp : (q == 1) ? -sp : (q == 2) ? -cp : sp;
}
__device__ __forceinline__ void tr_item(const float* W, int N, int n0, int k0, f16* WT, int ldk, int drow0, LAS float* scr, int lane) {
#pragma unroll 8
    for (int i = 0; i < 32; ++i) { const int kk = 2 * i + (lane >> 5); scr[kk * 33 + (lane & 31)] = (n0 >= 0) ? W[(size_t)(k0 + kk) * N + n0 + (lane & 31)] : 0.f; }
    LDS_WAIT(); asm volatile("" ::: "memory");
    const int c = lane & 7;
#pragma unroll
    for (int j = 0; j < 4; ++j) { const int n = (lane >> 3) + 8 * j; const LAS float* s = scr + (8 * c) * 33 + n;
        u32x4 o; o.x = pk2h(s[0 * 33], s[1 * 33]); o.y = pk2h(s[2 * 33], s[3 * 33]); o.z = pk2h(s[4 * 33], s[5 * 33]); o.w = pk2h(s[6 * 33], s[7 * 33]);
        *(u32x4*)(WT + (size_t)(drow0 + n) * ldk + k0 + 8 * c) = o; }
    LDS_WAIT(); asm volatile("" ::: "memory");
}
__device__ __forceinline__ void rms_row_to_f16(const float* xrow, const float* g, f16* orow, int lane) {
    const f32x4* xr = (const f32x4*)xrow + lane;
    f32x4 v[4]; float s = 0.f;
#pragma unroll
    for (int j = 0; j < 4; ++j) { v[j] = xr[64 * j]; s += (v[j].x * v[j].x + v[j].y * v[j].y) + (v[j].z * v[j].z + v[j].w * v[j].w); }
    const float rs = 1.0f / sqrtf(wave_sum(s) * (1.0f / DM) + EPS);
    u32x2* o8 = (u32x2*)orow + lane;
#pragma unroll
    for (int j = 0; j < 4; ++j) { const f32x4 gg = ((const f32x4*)g)[lane + 64 * j]; u32x2 w; w.x = pk2h(v[j].x * rs * gg.x, v[j].y * rs * gg.y); w.y = pk2h(v[j].z * rs * gg.z, v[j].w * rs * gg.w); o8[64 * j] = w; }
}
__device__ __forceinline__ void phase_rownorm(Frame& F, const float* x, const float* g) {
    const int gw = F.vcu * NWAVES + wave_id(), NGW = F.G * NWAVES;
    f16* XN = (f16*)(F.ws + WS_XN);
    for (int m = gw; m < T; m += NGW) rms_row_to_f16(x + (size_t)m * DM, g, XN + (size_t)m * DM, lane_id());
}
__device__ __forceinline__ void phase_prologue(Frame& F, const Args& args) {
    LAS float* scr = (LAS float*)(F.lds + wave_id() * 16384);
    const int gw = F.vcu * NWAVES + wave_id(), NGW = F.G * NWAVES;
    constexpr int I_IN = 16 * 80, I_O = 16 * 32, I_UP = 16 * 128, I_DN = 64 * 32, I_UQ = 4 * 16, I_UKV = 2 * 16;
    constexpr int PER_L = I_IN + I_O + I_UP + I_DN + I_UQ + I_UKV;
    for (int it = gw; it < DEPTH * PER_L; it += NGW) {
        const int l = it / PER_L; int r = it % PER_L;
        if (r < I_IN) { const int kb = r / 80, nb = r % 80, pn = nb >> 3, rem = nb & 7, bj = rem >> 2, wc = rem & 3; const int c0 = 256 * pn + 64 * wc + 32 * bj;
            const int oc = c0 < 1184 ? c0 : (c0 < 1280 ? -1 : c0 - 96);
            tr_item(args.in[I_WIN] + (size_t)l * DM * NIN, NIN, oc, 64 * kb, wt_ptr(F, l, WO_IN), DM, 32 * nb, scr, lane_id()); continue; } r -= I_IN;
        if (r < I_O) { const int kb = r / 32, nb = r % 32; tr_item(args.in[I_WO] + (size_t)l * DM * DM, DM, 32 * nb, 64 * kb, wt_ptr(F, l, WO_O), DM, 32 * nb, scr, lane_id()); continue; } r -= I_O;
        if (r < I_UP) { const int kb = r / 128, nb = r % 128; tr_item(args.in[I_WUP] + (size_t)l * DM * DFF, DFF, 32 * nb, 64 * kb, wt_ptr(F, l, WO_UP), DM, 32 * nb, scr, lane_id()); continue; } r -= I_UP;
        if (r < I_DN) { const int kb = r / 32, nb = r % 32; tr_item(args.in[I_WDOWN] + (size_t)l * DFF * DM, DM, 32 * nb, 64 * kb, wt_ptr(F, l, WO_DOWN), DFF, 32 * nb, scr, lane_id()); continue; } r -= I_DN;
        if (r < I_UQ) { const int kb = r / 16, nb = r % 16; tr_item(args.in[I_WUQ] + (size_t)l * 256 * 384, 384, nb < 12 ? 32 * nb : -1, 64 * kb, wt_ptr(F, l, WO_UQ), 256, 32 * nb, scr, lane_id()); continue; } r -= I_UQ;
        { const int kb = r / 16, nb = r % 16; tr_item(args.in[I_WUKV] + (size_t)l * 128 * 512, 512, 32 * nb, 64 * kb, wt_ptr(F, l, WO_UKV), 256, 32 * nb, scr, lane_id()); }
    }
    { const int gt = (F.vcu * NWAVES + wave_id()) * 64 + lane_id(), NGT = NGW * 64; const u32x4 z = {0u, 0u, 0u, 0u};
      for (int i = gt; i < DEPTH * 512 * 16; i += NGT) { const int l = i / (512 * 16), rr = (i / 16) % 512, ch = i % 16; *(u32x4*)(wt_ptr(F, l, WO_UKV) + (size_t)rr * 256 + 128 + 8 * ch) = z; }
      for (int i = gt; i < DEPTH * 2560; i += NGT) { const int l = i / 2560, pn = (i % 2560) / 256, d = i % 64, hh = (i % 256) / 64; float v = 0.f; float* gt_ = (float*)wt_ptr(F, l, WO_GT) - l * 2560;
          if (pn == 0) v = args.in[I_MQG][l * 64 + d] * C2_64; else if (pn == 1) v = args.in[I_MKG][l * 64 + d]; else if (pn == 5) v = args.in[I_CQG][l * 64 + d] * C2_64;
          else if (pn == 6) v = args.in[I_CKG][l * 64 + d]; else if (pn == 8) v = args.in[I_DQG][l * 64 + d] * C2_64; else if (pn == 9 && hh < 2) v = args.in[I_DKG][l * 64 + d];
          gt_[i] = v; }
      float* ct = (float*)(F.ws + WS_ROPE); float* st = ct + SEQ * 16;
      for (int i = gt; i < SEQ * 16; i += NGT) { const int pos = i / 16, j = i % 16; double invd = 1.0; for (int q = 0; q < j; ++q) invd *= 0.56234132519034908;
          const float ang = (float)pos * (float)invd; double cs, sn; sincos_d((double)ang, cs, sn); ct[i] = (float)cs; st[i] = (float)sn; }
    }
    phase_rownorm(F, args.in[I_X], args.in[I_ANG]);
}

__device__ __forceinline__ void phase_mla_pre(Frame& F, const Args& args, int l) {
    const int gw = F.vcu * NWAVES + wave_id(), NGW = F.G * NWAVES, lane = lane_id();
    const f16* HB = (const f16*)(F.ws + WS_HB); f16* QLN = (f16*)(F.ws + WS_QLN); f16* KVN = (f16*)(F.ws + WS_KVN);
    const float* gq = args.in[I_QLG] + l * 256; const float* gk = args.in[I_KVLG] + l * 128;
    for (int m = gw; m < T; m += NGW) {
        const f16* hr = HB + (size_t)m * HBP;
        const h4 q = *(const h4*)(hr + C_QL + 4 * lane); const h2 k = *(const h2*)(hr + C_KVL + 2 * lane);
        float qf[4], kf[2]; float sq = 0.f, sk = 0.f;
#pragma unroll
        for (int e = 0; e < 4; ++e) { qf[e] = (float)q[e]; sq += qf[e] * qf[e]; }
#pragma unroll
        for (int e = 0; e < 2; ++e) { kf[e] = (float)k[e]; sk += kf[e] * kf[e]; }
        const float rq = 1.0f / sqrtf(wave_sum(sq) * (1.0f / 256.0f) + EPS), rk = 1.0f / sqrtf(wave_sum(sk) * (1.0f / 128.0f) + EPS);
        const f32x4 g4 = *(const f32x4*)(gq + 4 * lane); const f32x2 g2 = *(const f32x2*)(gk + 2 * lane);
        u32x2 w; w.x = pk2h(qf[0] * rq * g4.x, qf[1] * rq * g4.y); w.y = pk2h(qf[2] * rq * g4.z, qf[3] * rq * g4.w);
        *(u32x2*)(QLN + (size_t)m * 256 + 4 * lane) = w;
        *(unsigned*)(KVN + (size_t)m * 256 + 2 * lane) = pk2h(kf[0] * rk * g2.x, kf[1] * rk * g2.y);
        *(unsigned*)(KVN + (size_t)m * 256 + 128 + 2 * lane) = 0u;
    }
    float* KMP = (float*)(F.ws + WS_KMP);
    for (int it = gw; it < BATCH * 32 * 4; it += NGW) { const int bb = it >> 2, h = it & 3; const f16* kp = HB + (size_t)bb * 256 * HBP + C_AK + 64 * h + lane;
        float s0 = 0.f, s1 = 0.f, s2 = 0.f, s3 = 0.f;
#pragma unroll 4
        for (int r = 0; r < 256; r += 4) { s0 += (float)kp[(size_t)r * HBP]; s1 += (float)kp[(size_t)(r + 1) * HBP]; s2 += (float)kp[(size_t)(r + 2) * HBP]; s3 += (float)kp[(size_t)(r + 3) * HBP]; }
        KMP[(size_t)it * 64 + lane] = ((s0 + s1) + (s2 + s3)) * (1.0f / 256.0f); }
}
__device__ __forceinline__ void phase_mla_post(Frame& F, const Args& args, int l) {
    const int gw = F.vcu * NWAVES + wave_id(), NGW = F.G * NWAVES, lane = lane_id();
    const f16* HB = (const f16*)(F.ws + WS_HB); const f16* QU = (const f16*)(F.ws + WS_QU); const f16* KVU = (const f16*)(F.ws + WS_KVU);
    f16* QB = (f16*)(F.ws + WS_QB); f16* KB = (f16*)(F.ws + WS_KB); f16* VB = (f16*)(F.ws + WS_VB);
    const float* gq = args.in[I_BQG] + l * 96; const float* gk = args.in[I_BKG] + l * 96;
    const float* ct = (const float*)(F.ws + WS_ROPE); const float* st = ct + SEQ * 16;
    const float gq0 = gq[lane], gk0 = gk[lane], gq1 = gq[64 + (lane & 31)], gk1 = gk[64 + (lane & 31)];
    for (int m = gw; m < T; m += NGW) {
        const int pos = m % SEQ; const float c = ct[pos * 16 + (lane & 15)], s = st[pos * 16 + (lane & 15)];
        const float kr = (float)HB[(size_t)m * HBP + C_KR + (lane & 31)];
#pragma unroll
        for (int h = 0; h < 4; ++h) {
            { const float a = (float)QU[(size_t)m * 512 + 96 * h + lane]; const float b = (float)QU[(size_t)m * 512 + 96 * h + 64 + (lane & 31)];
              const float ss = wave_sum(a * a + (lane < 32 ? b * b : 0.f)); const float rs = 1.0f / sqrtf(ss * (1.0f / 96.0f) + EPS);
              const float an = a * rs * gq0, bn = b * rs * gq1;
              const float other = __shfl_xor(bn, 16);
              const float r = ((lane & 16) == 0) ? (bn * c - other * s) : (other * s + bn * c);
              QB[(size_t)m * 384 + 96 * h + lane] = (f16)(an * C2_96);
              if (lane < 32) QB[(size_t)m * 384 + 96 * h + 64 + lane] = (f16)(r * C2_96); }
            { const float a = (float)KVU[(size_t)m * 512 + 128 * h + lane]; const float v = (float)KVU[(size_t)m * 512 + 128 * h + 64 + lane];
              const float ss = wave_sum(a * a + (lane < 32 ? kr * kr : 0.f)); const float rs = 1.0f / sqrtf(ss * (1.0f / 96.0f) + EPS);
              const float an = a * rs * gk0, bn = kr * rs * gk1;
              const float other = __shfl_xor(bn, 16);
              const float r = ((lane & 16) == 0) ? (bn * c - other * s) : (other * s + bn * c);
              KB[(size_t)m * 384 + 96 * h + lane] = (f16)an;
              if (lane < 32) KB[(size_t)m * 384 + 96 * h + 64 + lane] = (f16)r;
              VB[(size_t)m * 256 + 64 * h + lane] = (f16)v; }
        }
    }
}
__device__ __forceinline__ void phase_mix(Frame& F, const Args& args, int l) {
    const int gw = F.vcu * NWAVES + wave_id(), NGW = F.G * NWAVES, lane = lane_id();
    f16* OR = (f16*)(F.ws + WS_OR); const f16* CPO = (const f16*)(F.ws + WS_CPO); const float* CPML = (const float*)(F.ws + WS_CPML);
    const float* gog = args.in[I_GOG] + l * 1024;
    const int grp = lane >> 4;
    for (int m = gw; m < T; m += NGW) {
        float v[16];
        if (grp == 2) {
            const int cl = (lane - 32) * 16, h = cl >> 6;
            float mb[3], lb[3];
#pragma unroll
            for (int b = 0; b < 3; ++b) { const f32x2 ml = *(const f32x2*)(CPML + (((size_t)b * T + m) * 4 + h) * 2); mb[b] = ml.x; lb[b] = ml.y; }
            const float M = fmaxf(fmaxf(mb[0], mb[1]), mb[2]);
            float w[3], den = 0.f;
#pragma unroll
            for (int b = 0; b < 3; ++b) { w[b] = exp2f(mb[b] - M) * lb[b]; den += w[b]; }
#pragma unroll
            for (int e = 0; e < 16; ++e) v[e] = 0.f;
#pragma unroll
            for (int b = 0; b < 3; ++b) { const h8 x0 = *(const h8*)(CPO + ((size_t)b * T + m) * 256 + cl), x1 = *(const h8*)(CPO + ((size_t)b * T + m) * 256 + cl + 8);
#pragma unroll
                for (int e = 0; e < 8; ++e) { v[e] += w[b] * (float)x0[e]; v[8 + e] += w[b] * (float)x1[e]; } }
            const float inv = 1.0f / den;
#pragma unroll
            for (int e = 0; e < 16; ++e) v[e] *= inv;
        } else {
            const h8 x0 = *(const h8*)(OR + (size_t)m * DM + lane * 16), x1 = *(const h8*)(OR + (size_t)m * DM + lane * 16 + 8);
#pragma unroll
            for (int e = 0; e < 8; ++e) { v[e] = (float)x0[e]; v[8 + e] = (float)x1[e]; }
        }
        float ss = 0.f;
#pragma unroll
        for (int e = 0; e < 16; ++e) ss += v[e] * v[e];
        ss += __shfl_xor(ss, 1); ss += __shfl_xor(ss, 2); ss += __shfl_xor(ss, 4); ss += __shfl_xor(ss, 8);
        const float rs = 1.0f / sqrtf(ss * (1.0f / 256.0f) + EPS);
        const float* gg = gog + lane * 16;
        u32x4 w0, w1;
        w0.x = pk2h(v[0] * rs * gg[0], v[1] * rs * gg[1]); w0.y = pk2h(v[2] * rs * gg[2], v[3] * rs * gg[3]); w0.z = pk2h(v[4] * rs * gg[4], v[5] * rs * gg[5]); w0.w = pk2h(v[6] * rs * gg[6], v[7] * rs * gg[7]);
        w1.x = pk2h(v[8] * rs * gg[8], v[9] * rs * gg[9]); w1.y = pk2h(v[10] * rs * gg[10], v[11] * rs * gg[11]); w1.z = pk2h(v[12] * rs * gg[12], v[13] * rs * gg[13]); w1.w = pk2h(v[14] * rs * gg[14], v[15] * rs * gg[15]);
        *(u32x4*)(OR + (size_t)m * DM + lane * 16) = w0; *(u32x4*)(OR + (size_t)m * DM + lane * 16 + 8) = w1;
    }
}

template <int D> __device__ __forceinline__ float dotq(const float (&q)[D], const f16* kr) {
    float s0 = 0.f, s1 = 0.f;
#pragma unroll
    for (int c = 0; c < D / 8; ++c) { const h8 kv = *(const h8*)(kr + 8 * c);
#pragma unroll
        for (int j = 0; j < 8; j += 2) { s0 += q[8 * c + j] * (float)kv[j]; s1 += q[8 * c + j + 1] * (float)kv[j + 1]; } }
    return s0 + s1;
}
__device__ __forceinline__ void axpy64(float (&o)[64], float p, const f16* vr) {
#pragma unroll
    for (int c = 0; c < 8; ++c) { const h8 vv = *(const h8*)(vr + 8 * c);
#pragma unroll
        for (int j = 0; j < 8; ++j) o[8 * c + j] += p * (float)vv[j]; }
}
template <int D> __device__ __forceinline__ void loadq(float (&q)[D], const f16* qr) {
#pragma unroll
    for (int c = 0; c < D / 8; ++c) { const h8 v = *(const h8*)(qr + 8 * c);
#pragma unroll
        for (int j = 0; j < 8; ++j) q[8 * c + j] = (float)v[j]; }
}
__device__ __forceinline__ void store64(f16* orow, const float (&o)[64], float inv) {
#pragma unroll
    for (int c = 0; c < 8; ++c) { u32x4 w; w.x = pk2h(o[8 * c] * inv, o[8 * c + 1] * inv); w.y = pk2h(o[8 * c + 2] * inv, o[8 * c + 3] * inv); w.z = pk2h(o[8 * c + 4] * inv, o[8 * c + 5] * inv); w.w = pk2h(o[8 * c + 6] * inv, o[8 * c + 7] * inv);
        *(u32x4*)(orow + 8 * c) = w; }
}
#define KEYSTEP(DQ, vld_, bias_, krow_, vrow_) do { const bool vld = (vld_); const float s = dotq<DQ>(q, (krow_)) + (bias_); \
    if (__any(vld && s > m)) { const float mn = vld ? fmaxf(m, s) : m; const float f = __builtin_amdgcn_exp2f(m - mn); l *= f; _Pragma("unroll") for (int d_ = 0; d_ < 64; ++d_) o[d_] *= f; m = mn; } \
    const float p = vld ? __builtin_amdgcn_exp2f(s - m) : 0.f; l += p; axpy64(o, p, (vrow_)); } while (0)

__device__ __forceinline__ float alibi_slope(int idx) { return exp2f((-8.0f * (float)idx) / 12.0f); }

__device__ __forceinline__ void valu_moba(Frame& F, int b, int h, int c) {
    const int lane = lane_id(); const f16* HB = (const f16*)(F.ws + WS_HB); const float* KMP = (const float*)(F.ws + WS_KMP); f16* OR = (f16*)(F.ws + WS_OR);
    const int t = 64 * c + lane; const size_t row = (size_t)b * SEQ + t; const int qblk = c >> 2;
    float q[64]; loadq<64>(q, HB + row * HBP + C_AQ + 64 * h);
    float v1 = -INFINITY, v2 = -INFINITY, v3 = -INFINITY; int i1 = -1, i2 = -1, i3 = -1;
    for (int j = 0; j < qblk; ++j) {
        const float* k0 = KMP + ((size_t)(b * 32 + j) * 4 + h) * 64;
        float g = 0.f;
#pragma unroll
        for (int d = 0; d < 64; ++d) g += q[d] * k0[d];
        if (g > v1) { v3 = v2; i3 = i2; v2 = v1; i2 = i1; v1 = g; i1 = j; } else if (g > v2) { v3 = v2; i3 = i2; v2 = g; i2 = j; } else if (g > v3) { v3 = g; i3 = j; }
    }
    unsigned sel = 0u; if (i1 >= 0) sel |= 1u << i1; if (i2 >= 0) sel |= 1u << i2; if (i3 >= 0) sel |= 1u << i3;
    const float sl2 = alibi_slope(1 + 3 * h) * LOG2E;
    float o[64]; float m = -1e30f, l = 0.f;
#pragma unroll
    for (int d = 0; d < 64; ++d) o[d] = 0.f;
    for (int j = 0; j <= qblk; ++j) {
        const bool mine = (j == qblk) || ((sel >> j) & 1u);
        if (!__any(mine)) continue;
        const int kend = (j == qblk) ? min(256, 64 * (c & 3) + 64) : 256;
        for (int kk = 0; kk < kend; ++kk) { const int kpos = 256 * j + kk; const f16* kr = HB + ((size_t)b * SEQ + kpos) * HBP;
            KEYSTEP(64, mine && kpos <= t, sl2 * (float)(kpos - t), kr + C_AK + 64 * h, kr + C_AV + 64 * h); }
    }
    store64(OR + row * DM + 0 + 64 * h, o, 1.0f / l);
}
__device__ __forceinline__ void valu_mla(Frame& F, int b, int h, int c) {
    const int lane = lane_id(); const f16* QB = (const f16*)(F.ws + WS_QB); const f16* KB = (const f16*)(F.ws + WS_KB); const f16* VB = (const f16*)(F.ws + WS_VB); f16* OR = (f16*)(F.ws + WS_OR);
    const int t = 64 * c + lane; const size_t row = (size_t)b * SEQ + t;
    float q[96]; loadq<96>(q, QB + row * 384 + 96 * h);
    float o[64]; float m = -1e30f, l = 0.f;
#pragma unroll
    for (int d = 0; d < 64; ++d) o[d] = 0.f;
    const int kend = 64 * c + 64;
    for (int kpos = 0; kpos < kend; ++kpos) { const size_t rk = (size_t)b * SEQ + kpos;
        KEYSTEP(96, kpos <= t, 0.f, KB + rk * 384 + 96 * h, VB + rk * 256 + 64 * h); }
    store64(OR + row * DM + 256 + 64 * h, o, 1.0f / l);
}
__device__ __forceinline__ void valu_dil(Frame& F, int b, int h, int br, int r, int n, int hf) {
    const int lane = lane_id(); const f16* HB = (const f16*)(F.ws + WS_HB); f16* CPO = (f16*)(F.ws + WS_CPO); float* CPML = (float*)(F.ws + WS_CPML);
    const int d = (br == 0) ? 1 : (br == 1 ? 4 : 16);
    const int i = 64 * hf + lane; const int t = (128 * n + i) * d + r; const size_t row = (size_t)b * SEQ + t;
    float q[64]; loadq<64>(q, HB + row * HBP + C_CQ + 64 * h);
    const float sl2 = alibi_slope(2 + 3 * h) * LOG2E * (float)d;
    float o[64]; float m = -1e30f, l = 0.f;
#pragma unroll
    for (int dd = 0; dd < 64; ++dd) o[dd] = 0.f;
    for (int kidx = 64 * hf; kidx < 64 * hf + 192; ++kidx) { const int sp = 128 * (n - 1) + kidx; if (sp < 0) continue;
        const int kpos = sp * d + r; const int rel = i + 128 - kidx; const f16* kr = HB + ((size_t)b * SEQ + kpos) * HBP;
        KEYSTEP(64, rel >= 0 && rel <= 128, -sl2 * (float)rel, kr + C_CK + 64 * h, kr + C_CV + 64 * h); }
    store64(CPO + ((size_t)br * T + row) * 256 + 64 * h, o, 1.0f / l);
    *(f32x2*)(CPML + (((size_t)br * T + row) * 4 + h) * 2) = (f32x2){m, l};
}
__device__ __forceinline__ void valu_swa(Frame& F, const Args& args, int l_, int b, int hq, int n, int hf) {
    const int lane = lane_id(); const f16* HB = (const f16*)(F.ws + WS_HB); f16* OR = (f16*)(F.ws + WS_OR);
    const int kvh = hq >> 1; const int i = 64 * hf + lane; const int t = 128 * n + i; const size_t row = (size_t)b * SEQ + t;
    float q[64]; loadq<64>(q, HB + row * HBP + C_DQ + 64 * hq);
    const float sl2 = alibi_slope(3 + 3 * hq) * LOG2E;
    float o[64]; float m = -1e30f, l = 0.f;
#pragma unroll
    for (int dd = 0; dd < 64; ++dd) o[dd] = 0.f;
    for (int kidx = 64 * hf; kidx < 64 * hf + 192; ++kidx) { const int kpos = 128 * (n - 1) + kidx; if (kpos < 0) continue;
        const int rel = i + 128 - kidx; const f16* kr = HB + ((size_t)b * SEQ + kpos) * HBP;
        KEYSTEP(64, rel >= 0 && rel < 128, -sl2 * (float)rel, kr + C_DK + 64 * kvh, kr + C_DV + 64 * kvh); }
    const float sk = args.in[I_SINK][l_ * 4 + hq] * LOG2E; const float M = fmaxf(m, sk);
    const float f = __builtin_amdgcn_exp2f(m - M); const float den = l * f + __builtin_amdgcn_exp2f(sk - M);
    store64(OR + row * DM + 768 + 64 * hq, o, f / den);
}
__device__ __forceinline__ void phase_attn_valu(Frame& F, const Args& args, int l) {
    const int gw = __builtin_amdgcn_readfirstlane(F.vcu * NWAVES + wave_id()), NGW = F.G * NWAVES;
    constexpr int NB = 1024, NA = 1024, NC = 3072, ND = 1024;
    for (int u = gw; u < NB + NA + NC + ND; u += NGW) {
        int r = u;
        if (r < NB) { const int c = 127 - (r >> 3), bh = r & 7; valu_mla(F, bh >> 2, bh & 3, c); continue; } r -= NB;
        if (r < NA) { const int c = 127 - (r >> 3), bh = r & 7; valu_moba(F, bh >> 2, bh & 3, c); continue; } r -= NA;
        if (r < NC) { const int hf = r & 1, bh = (r >> 1) & 7, rn = (r >> 4) & 63, br = r >> 10; const int d = (br == 0) ? 1 : (br == 1 ? 4 : 16); const int nbk = 64 / d;
            valu_dil(F, bh >> 2, bh & 3, br, rn / nbk, rn % nbk, hf); continue; } r -= NC;
        { const int hf = r & 1, bh = (r >> 1) & 7, n = r >> 4; valu_swa(F, args, l, bh >> 2, bh & 3, n, hf); }
    }
}

#ifndef PHMASK
#define PHMASK 0xfff
#endif
constexpr int PH_PER_LAYER = 11, N_PHASES = 1 + DEPTH * PH_PER_LAYER;
#define PH_FENCE() asm volatile("" ::: "memory")
template <int L> __device__ __forceinline__ void run_layer(Frame& F, const Args& args, int lo, int hi) {
    constexpr int P0 = 1 + L * PH_PER_LAYER;
#define IN(k) (((PHMASK >> (k)) & 1) && lo <= P0 + (k) && P0 + (k) < hi)
    if (IN(0)) {
        PH_FENCE();
        pg8::Gemm g{(const f16*)(F.ws + WS_XN), wt_ptr(F, L, WO_IN), T, HBP, DM, DM}; pg8::StaticOrder S; S.init(T, HBP, F.G, (int)blockIdx.x);
        pg8::EpiIn E{(f16*)(F.ws + WS_HB), (const float*)wt_ptr(F, L, WO_GT)};
        pg8::gemm_phase<pg8::EpiIn, true, true>(F.lds, g, S, E); }
    if (IN(1)) { PH_FENCE(); phase_mla_pre(F, args, L); }
    if (IN(2)) {
        PH_FENCE();
        const bool second = (int)blockIdx.x >= F.G / 2;
        pg8::Gemm g{(const f16*)(F.ws + (second ? WS_KVN : WS_QLN)), wt_ptr(F, L, second ? WO_UKV : WO_UQ), T, 512, 256, 256}; pg8::StaticOrder S; S.init(T, 512, F.G / 2, (int)blockIdx.x % (F.G / 2));
        pg8::EpiF16<0> E{(f16*)(F.ws + (second ? WS_KVU : WS_QU)), 512}; pg8::gemm_phase<pg8::EpiF16<0>, true, true>(F.lds, g, S, E); }
    if (IN(3)) { PH_FENCE(); phase_mla_post(F, args, L); }
    if (IN(4)) { PH_FENCE(); phase_attn_valu(F, args, L); }
    if (IN(5)) { PH_FENCE(); phase_mix(F, args, L); }
    if (IN(6)) {
        PH_FENCE();
        pg8::Gemm g{(const f16*)(F.ws + WS_OR), wt_ptr(F, L, WO_O), T, DM, DM, DM}; pg8::StaticOrder S; S.init(T, DM, F.G, (int)blockIdx.x);
        pg8::EpiRes E{L == 0 ? args.in[I_X] : F.out, F.out, DM}; pg8::gemm_phase<pg8::EpiRes, true, true>(F.lds, g, S, E); }
    if (IN(7)) { PH_FENCE(); phase_rownorm(F, F.out, args.in[I_MNG] + L * DM); }
    if (IN(8)) {
        PH_FENCE();
        pg8::Gemm g{(const f16*)(F.ws + WS_XN), wt_ptr(F, L, WO_UP), T, DFF, DM, DM}; pg8::StaticOrder S; S.init(T, DFF, F.G, (int)blockIdx.x);
        pg8::EpiF16<1> E{(f16*)(F.ws + WS_H), DFF}; pg8::gemm_phase<pg8::EpiF16<1>, true, true>(F.lds, g, S, E); }
    if (IN(9)) {
        PH_FENCE();
        pg8::Gemm g{(const f16*)(F.ws + WS_H), wt_ptr(F, L, WO_DOWN), T, DM, DFF, DFF}; pg8::StaticOrder S; S.init(T, DM, F.G, (int)blockIdx.x);
        pg8::EpiRes E{F.out, F.out, DM}; pg8::gemm_phase<pg8::EpiRes, true, true>(F.lds, g, S, E); }
    if (L + 1 < DEPTH) { if (IN(10)) { PH_FENCE(); phase_rownorm(F, F.out, args.in[I_ANG] + (L + 1) * DM); } }
#undef IN
}
__global__ void __launch_bounds__(NWAVES * 64, 2) mega(Args args) {
    extern __shared__ __attribute__((aligned(16))) unsigned char lds_raw[];
    Frame F;
    F.lds = (LAS unsigned char*)lds_raw;
        F.G = gridDim.x; { const int bx = blockIdx.x; F.vcu = (F.G % 8 == 0) ? (bx % 8) * (F.G / 8) + bx / 8 : bx; }
    F.out = args.out; F.ws = args.ws;
    const int lo = args.ph_lo, hi = args.ph_hi;
    if ((PHMASK & 0x800) && lo <= 0 && 0 < hi) phase_prologue(F, args);
    run_layer<0>(F, args, lo, hi);
    run_layer<1>(F, args, lo, hi);
}

extern "C" void kernel_launch(void* const* d_in, const int* in_sizes, int n_in, void* d_out, int out_size, void* d_ws, size_t ws_size, hipStream_t stream) {
    static int grid = 0;
    if (grid == 0) {
        if (n_in != 21 || out_size != T * DM || ws_size < WS_END) { fprintf(stderr, "kernel_launch: unexpected shapes (n_in %d, out %d, ws %zu)\n", n_in, out_size, ws_size); grid = -1; return; }
        if (hipFuncSetAttribute((const void*)mega, hipFuncAttributeMaxDynamicSharedMemorySize, LDS_BYTES) != hipSuccess) { fprintf(stderr, "kernel_launch: hipFuncSetAttribute failed\n"); grid = -1; return; }
        int dev = 0, cus = 0; hipGetDevice(&dev); hipDeviceGetAttribute(&cus, hipDeviceAttributeMultiprocessorCount, dev);
        grid = cus > 0 ? cus : 256;
    }
    if (grid < 0) return;
    Args a{};
    for (int i = 0; i < 21; ++i) a.in[i] = (const float*)d_in[i];
    a.out = (float*)d_out; a.ws = (unsigned char*)d_ws;
    for (int ph = 0; ph < N_PHASES; ++ph) {
        if (ph == N_PHASES - 1) break;
        a.ph_lo = ph; a.ph_hi = ph + 1; a.li = ph;
        hipLaunchKernelGGL(mega, dim3(grid), dim3(NWAVES * 64), LDS_BYTES, stream, a);
    }
}
```

```cpp
#include <hip/hip_runtime.h>
#include <cstdio>
#include <cstdint>
#include <cmath>

#ifndef ATT_VALU
#define ATT_VALU 0
#endif
#define LAS __attribute__((address_space(3)))
#define GAS __attribute__((address_space(1)))
typedef _Float16 f16;
typedef _Float16 h8 __attribute__((ext_vector_type(8)));
typedef _Float16 h4 __attribute__((ext_vector_type(4)));
typedef _Float16 h2 __attribute__((ext_vector_type(2)));
typedef float f32x4 __attribute__((ext_vector_type(4)));
typedef float f32x2 __attribute__((ext_vector_type(2)));
typedef unsigned u32x4 __attribute__((ext_vector_type(4)));
typedef unsigned u32x2 __attribute__((ext_vector_type(2)));


__device__ __forceinline__ void st16f(void* p, f32x4 v) { *(f32x4*)p = v; }
__device__ __forceinline__ void st8(void* p, u32x2 v) { *(u32x2*)p = v; }

constexpr int BATCH = 2, SEQ = 8192, DM = 1024, T = BATCH * SEQ, DEPTH = 2;
constexpr int NIN = 2464, HBP = 2560, DFF = 4096;
constexpr float EPS = 1e-6f;
constexpr float LOG2E = 1.4426950408889634f;
constexpr float C2_64 = 0.125f * LOG2E;
constexpr float C2_96 = 0.10206207261596577f * LOG2E;
constexpr int C_AQ = 0, C_AK = 256, C_AV = 512, C_QL = 768, C_KVL = 1024, C_KR = 1152, C_CQ = 1280, C_CK = 1536, C_CV = 1792, C_DQ = 2048, C_DK = 2304, C_DV = 2432;

constexpr size_t MiB = 1u << 20;
constexpr size_t WS_CTL = 0;
constexpr size_t WS_W = 1 * MiB, W_LAYER = 24 * MiB;
constexpr size_t WO_IN = 0, WO_O = 5 * MiB, WO_UP = 7 * MiB, WO_DOWN = 15 * MiB, WO_UQ = 23 * MiB, WO_UKV = 23 * MiB + 256 * 1024, WO_GT = 23 * MiB + 512 * 1024;
constexpr size_t WS_ROPE = 49 * MiB;
constexpr size_t WS_XN = 50 * MiB;
constexpr size_t OUT_CPO = 0;
constexpr size_t OUT_PA2 = 24 * MiB;
constexpr size_t WS_RS = 246 * MiB;
constexpr size_t WS_HB = 82 * MiB;
constexpr size_t WS_QB = 162 * MiB, WS_KB = 174 * MiB, WS_VB = 186 * MiB;
constexpr size_t WS_QLN = 194 * MiB, WS_KVN = 202 * MiB;
constexpr size_t WS_KMP = 242 * MiB;
constexpr size_t WS_XBUF = 245 * MiB;
constexpr size_t WS_CPML = 243 * MiB;
constexpr size_t WS_H = 82 * MiB;
constexpr size_t WS_OR = 210 * MiB;
constexpr size_t WS_QU = 210 * MiB, WS_KVU = 226 * MiB;
constexpr size_t WS_PA01 = 194 * MiB;
constexpr size_t WS_LSS = 246 * MiB + 256 * 1024;
constexpr size_t WS_LIST = 247 * MiB;
constexpr size_t WS_PAML = 249 * MiB;
constexpr int LIST_STRIDE = 126976;
constexpr int CW_LCNT = 12288;
constexpr size_t WS_END = 256 * MiB;

namespace pg8 {
constexpr int BM = 256, BK = 64, HALF = 128, HTB = HALF * BK * 2, STAGE_BYTES = 8 * HTB, NXCD = 8, WGM = 8;
__host__ __device__ __forceinline__ int lds_byte(int r, int c) { const int st = (r >> 4) * 2 + (c >> 5), rr = r & 15, cc = c & 31, ob = rr * 64 + cc * 2; return st * 1024 + (ob ^ (((ob >> 9) & 1) << 5)); }
__host__ __device__ __forceinline__ void stage_rc(int b, int& R, int& C) { const int st = b / 1024, sb = b % 1024, swz = sb ^ (((sb >> 9) & 1) << 5); R = (st >> 1) * 16 + swz / 64; C = (st & 1) * 32 + (swz % 64) / 2; }
__host__ __device__ __forceinline__ int perm32(int rho) { const int n = rho >> 4, i = rho & 15; return 8 * (i >> 2) + 4 * n + (i & 3); }
struct Unit { int pm, pn; };
struct Gemm { const f16* A; const f16* Bt; int M, N, K, lda; };
struct StaticOrder {
    int nM, nN, nwg, G, c;
    __device__ __forceinline__ void init(int M, int N, int G_, int c_) { nM = M / BM; nN = N / BM; nwg = nM * nN; G = G_; c = c_; }
    __device__ __forceinline__ bool next(int i, Unit& u) const {
        const long L = (long)i * G + c; if (L >= nwg) return false;
        int wgid = (int)L; { const int q = nwg / NXCD, r = nwg % NXCD, xcd = wgid % NXCD, off = wgid / NXCD; wgid = (xcd < r ? xcd * (q + 1) : r * (q + 1) + (xcd - r) * q) + off; }
        const int nig = WGM * nN, gid = wgid / nig, fm = gid * WGM, gsz = (nM - fm) < WGM ? (nM - fm) : WGM;
        u.pm = fm + ((wgid % nig) % gsz); u.pn = (wgid % nig) / gsz; return true;
    }
};
__device__ __forceinline__ u32x4 pack8(f32x4 a, f32x4 b) {
    u32x4 w;
    w.x = __builtin_bit_cast(unsigned, __builtin_convertvector((f32x2){a[0], a[1]}, h2));
    w.y = __builtin_bit_cast(unsigned, __builtin_convertvector((f32x2){a[2], a[3]}, h2));
    w.z = __builtin_bit_cast(unsigned, __builtin_convertvector((f32x2){b[0], b[1]}, h2));
    w.w = __builtin_bit_cast(unsigned, __builtin_convertvector((f32x2){b[2], b[3]}, h2));
    return w;
}
__device__ __forceinline__ float row16_sum(float a) {
    a += __builtin_bit_cast(float, __builtin_amdgcn_update_dpp(0, __builtin_bit_cast(int, a), 0x128, 0xf, 0xf, false));
    a += __builtin_bit_cast(float, __builtin_amdgcn_update_dpp(0, __builtin_bit_cast(int, a), 0x124, 0xf, 0xf, false));
    a += __builtin_bit_cast(float, __builtin_amdgcn_update_dpp(0, __builtin_bit_cast(int, a), 0x122, 0xf, 0xf, false));
    a += __builtin_bit_cast(float, __builtin_amdgcn_update_dpp(0, __builtin_bit_cast(int, a), 0x121, 0xf, 0xf, false));
    return a;
}
__device__ __forceinline__ float rstd_row(const float* xb, int row) { const f32x4 p = *(const f32x4*)(xb + (size_t)row * 4); return __builtin_amdgcn_rsqf(((p[0] + p[1]) + (p[2] + p[3])) * (1.0f / 1024.0f) + EPS); }
template <int ACT> struct EpiF16 {
    static constexpr bool PERM = true, AFTER_DRAIN = false;
    f16* O; int ldc; const float* RS;
    __device__ __forceinline__ void operator()(const f32x4 (&acc)[2][2][4][2], const Unit& u, int wr, int wc) const {
        int lane_ = threadIdx.x & 63; asm volatile("" : "+v"(lane_)); const int fr = lane_ & 15, fq = lane_ >> 4;
        const int row0 = u.pm * BM + wr * 64 + fr, col0 = u.pn * BM + wc * 32 + 8 * fq;
#pragma unroll
        for (int ai = 0; ai < 2; ++ai)
#pragma unroll
            for (int m = 0; m < 4; ++m) { f16* rowp = O + (size_t)(row0 + ai * HALF + m * 16) * ldc + col0; const float rsr = RS ? rstd_row(RS, row0 + ai * HALF + m * 16) : 1.0f;
#pragma unroll
                for (int bj = 0; bj < 2; ++bj) { f32x4 v0 = acc[ai][bj][m][0] * rsr, v1 = acc[ai][bj][m][1] * rsr;
                    if (ACT == 1) {
#pragma unroll
                        for (int e = 0; e < 4; ++e) { const float a = fmaxf(v0[e], 0.f), b = fmaxf(v1[e], 0.f); v0[e] = a * a; v1[e] = b * b; } }
                    *(u32x4*)(rowp + bj * HALF) = pack8(v0, v1); } }
    }
};
struct EpiRes {
    static constexpr bool PERM = false, AFTER_DRAIN = false;
    const float* base; float* out; int ldc;
    __device__ __forceinline__ void operator()(const f32x4 (&acc)[2][2][4][2], const Unit& u, int wr, int wc) const {
        int lane_ = threadIdx.x & 63; asm volatile("" : "+v"(lane_)); const int fr = lane_ & 15, fq = lane_ >> 4;
        const int row0 = u.pm * BM + wr * 64 + fr, col0 = u.pn * BM + wc * 32 + 4 * fq;
#pragma unroll
        for (int ai = 0; ai < 2; ++ai)
#pragma unroll
            for (int m = 0; m < 4; ++m) { const size_t off = (size_t)(row0 + ai * HALF + m * 16) * ldc + col0;
#pragma unroll
                for (int bj = 0; bj < 2; ++bj)
#pragma unroll
                    for (int n = 0; n < 2; ++n) { const f32x4 b = *(const f32x4*)(base + off + bj * HALF + n * 16); *(f32x4*)(out + off + bj * HALF + n * 16) = b + acc[ai][bj][m][n]; } }
    }
};

struct EpiResNorm {
    static constexpr bool PERM = true, AFTER_DRAIN = true, INIT_ACC = true;
    f16* X16; float* outf; float* xbuf; int do_norm;
    __device__ __forceinline__ void init(f32x4 (&acc)[2][2][4][2], const Unit& u, int wr, int wc) const {
        int tid_ = threadIdx.x; asm volatile("" : "+v"(tid_)); const int lane = tid_ & 63, fr = lane & 15, fq = lane >> 4;
        const int row0 = u.pm * BM + wr * 64 + fr, col0 = u.pn * BM + wc * 32 + 8 * fq;
        h8 rb[2][4][2];
#pragma unroll
        for (int ai = 0; ai < 2; ++ai)
#pragma unroll
            for (int m = 0; m < 4; ++m) { const size_t off = (size_t)(row0 + ai * HALF + m * 16) * 1024 + col0;
#pragma unroll
                for (int bj = 0; bj < 2; ++bj) rb[ai][m][bj] = *(const h8*)(X16 + off + bj * HALF); }
#pragma unroll
        for (int ai = 0; ai < 2; ++ai)
#pragma unroll
            for (int m = 0; m < 4; ++m)
#pragma unroll
                for (int bj = 0; bj < 2; ++bj) { const h8 b = rb[ai][m][bj];
                    acc[ai][bj][m][0] = (f32x4){(float)b[0], (float)b[1], (float)b[2], (float)b[3]}; acc[ai][bj][m][1] = (f32x4){(float)b[4], (float)b[5], (float)b[6], (float)b[7]}; }
    }
    __device__ __forceinline__ void fused(f32x4 (&acc)[2][2][4][2], const Unit& u, int wr, int wc, LAS unsigned char* lds) const {
        int tid_ = threadIdx.x; asm volatile("" : "+v"(tid_)); const int lane = tid_ & 63, wid = __builtin_amdgcn_readfirstlane(tid_ >> 6), fr = lane & 15, fq = lane >> 4;
        const int row0 = u.pm * BM + wr * 64 + fr, col0 = u.pn * BM + wc * 32 + 8 * fq;
#pragma unroll
        for (int ai = 0; ai < 2; ++ai)
#pragma unroll
            for (int m = 0; m < 4; ++m) { const size_t off = (size_t)(row0 + ai * HALF + m * 16) * 1024 + col0;
#pragma unroll
                for (int bj = 0; bj < 2; ++bj) {
                    const f32x4 v0 = acc[ai][bj][m][0], v1 = acc[ai][bj][m][1];
                    if (outf) { st16f(outf + off + bj * HALF, v0); st16f(outf + off + bj * HALF + 4, v1); }
                    else *(u32x4*)(X16 + off + bj * HALF) = pack8(v0, v1); } }
        if (!do_norm) return;
        LAS float* P = (LAS float*)lds;
#pragma unroll
        for (int ai = 0; ai < 2; ++ai)
#pragma unroll
            for (int m = 0; m < 4; ++m) { float s = 0.f;
#pragma unroll
                for (int bj = 0; bj < 2; ++bj)
#pragma unroll
                    for (int n = 0; n < 2; ++n) { const f32x4 x = acc[ai][bj][m][n]; s += (x[0] * x[0] + x[1] * x[1]) + (x[2] * x[2] + x[3] * x[3]); }
                s += __shfl_xor(s, 16); s += __shfl_xor(s, 32);
                if (fq == 0) P[(ai * HALF + wr * 64 + m * 16 + fr) * 4 + wc] = s; }
        asm volatile("s_waitcnt lgkmcnt(0)" ::: "memory"); __builtin_amdgcn_s_barrier(); asm volatile("" ::: "memory");
        const int row = wid * 32 + (lane & 31);
        if (lane < 32) { const f32x4 p = *(const LAS f32x4*)(P + row * 4); xbuf[(size_t)(u.pm * BM + row) * 4 + u.pn] = (p[0] + p[1]) + (p[2] + p[3]); }
    }
};
struct EpiIn {
    static constexpr bool PERM = true, AFTER_DRAIN = false;
    f16* HB; const float* GT; int pn0; const float* RS; float* LSS;
    __device__ __forceinline__ void operator()(const f32x4 (&acc)[2][2][4][2], const Unit& u, int wr, int wc) const {
        int lane_ = threadIdx.x & 63; asm volatile("" : "+v"(lane_)); const int fr = lane_ & 15, fq = lane_ >> 4;
        const int pn = u.pn + pn0;
        const bool normed = (pn == 0) | (pn == 1) | (pn == 5) | (pn == 6) | (pn == 8) | ((pn == 9) & (wc < 2));
        const float* g = normed ? GT + (pn * 4 + wc) * 64 : nullptr;
        const int row0 = u.pm * BM + wr * 64 + fr, col0 = pn * BM + wc * 64 + 8 * fq;
        asm volatile("" : "+s"(g));
        if (g) {
            float rs[2][4];
#pragma unroll
            for (int ai = 0; ai < 2; ++ai)
#pragma unroll
                for (int m = 0; m < 4; ++m) {
                    float ss = 0.f;
#pragma unroll
                    for (int bj = 0; bj < 2; ++bj)
#pragma unroll
                        for (int n = 0; n < 2; ++n) { const f32x4 x = acc[ai][bj][m][n]; ss += (x[0] * x[0] + x[1] * x[1]) + (x[2] * x[2] + x[3] * x[3]); }
                    ss += __shfl_xor(ss, 16); ss += __shfl_xor(ss, 32);
                    const float rr = rstd_row(RS, row0 + ai * HALF + m * 16); ss *= rr * rr;
                    rs[ai][m] = rr * __builtin_amdgcn_rsqf(ss * (1.0f / 64.0f) + EPS);
                }
#pragma unroll
            for (int bj = 0; bj < 2; ++bj) {
                const f32x4 g0 = *(const f32x4*)(g + 32 * bj + 8 * fq), g1 = *(const f32x4*)(g + 32 * bj + 8 * fq + 4);
#pragma unroll
                for (int ai = 0; ai < 2; ++ai)
#pragma unroll
                    for (int m = 0; m < 4; ++m) { const f32x4 v0 = acc[ai][bj][m][0] * rs[ai][m] * g0, v1 = acc[ai][bj][m][1] * rs[ai][m] * g1;
                        *(u32x4*)(HB + (size_t)(row0 + ai * HALF + m * 16) * HBP + col0 + bj * 32) = pack8(v0, v1);
                        if (m & 1) asm volatile("" ::: "memory"); }
            }
        } else {
#pragma unroll
            for (int ai = 0; ai < 2; ++ai)
#pragma unroll
                for (int m = 0; m < 4; ++m) { f16* rowp = HB + (size_t)(row0 + ai * HALF + m * 16) * HBP + col0; const float rr = rstd_row(RS, row0 + ai * HALF + m * 16);
#pragma unroll
                    for (int bj = 0; bj < 2; ++bj) *(u32x4*)(rowp + bj * 32) = pack8(acc[ai][bj][m][0] * rr, acc[ai][bj][m][1] * rr); }
            if (LSS && ((pn == 3) | ((pn == 4) & (wc < 2)))) {
#pragma unroll
                for (int ai = 0; ai < 2; ++ai)
#pragma unroll
                    for (int m = 0; m < 4; ++m) { const int row = row0 + ai * HALF + m * 16; const float rr = rstd_row(RS, row); float ss = 0.f;
#pragma unroll
                        for (int bj = 0; bj < 2; ++bj)
#pragma unroll
                            for (int n = 0; n < 2; ++n) { const f32x4 x = acc[ai][bj][m][n]; ss += (x[0] * x[0] + x[1] * x[1]) + (x[2] * x[2] + x[3] * x[3]); }
                        ss += __shfl_xor(ss, 16); ss += __shfl_xor(ss, 32);
                        if (fq == 0) LSS[((size_t)(pn - 3) * T + row) * 4 + wc] = ss * rr * rr; } }
        }
    }
};

struct EpiMlaQ {
    static constexpr bool PERM = true, AFTER_DRAIN = true;
    f16* QB; const float* LSS; const float* gq; const float* ct; const float* st;
    __device__ __forceinline__ void fused(f32x4 (&acc)[2][2][4][2], const Unit& u, int wr, int wc, LAS unsigned char* lds) const {
        int tid_ = threadIdx.x; asm volatile("" : "+v"(tid_)); const int lane = tid_ & 63, fr = lane & 15, fq = lane >> 4;
        const int row0 = u.pm * BM + wr * 64 + fr, head = 2 * u.pn + (wc >> 1); const bool rope = (wc & 1) != 0;
        LAS float* P = (LAS float*)lds;
        f32x4 lp[2][4];
#pragma unroll
        for (int ai = 0; ai < 2; ++ai)
#pragma unroll
            for (int m = 0; m < 4; ++m) lp[ai][m] = *(const f32x4*)(LSS + (size_t)(row0 + ai * HALF + m * 16) * 4);
        f32x4 g0[2], g1[2];
        if (!rope) {
#pragma unroll
            for (int bj = 0; bj < 2; ++bj) { g0[bj] = *(const f32x4*)(gq + 32 * bj + 8 * fq) * C2_96; g1[bj] = *(const f32x4*)(gq + 32 * bj + 8 * fq + 4) * C2_96; } }
        else { g0[0] = *(const f32x4*)(gq + 64 + 8 * fq) * C2_96; g1[0] = *(const f32x4*)(gq + 64 + 8 * fq + 4) * C2_96; g0[1] = g0[0]; g1[1] = g1[0]; }
        f32x4 cs[2][4];
#define MLA_CS(dst, I) do { const int pos_ = (row0 + ((I) >> 2) * HALF + ((I) & 3) * 16) % SEQ; const float* cp_ = ct + pos_ * 16 + 8 * (fq & 1); const float* sp_ = st + pos_ * 16 + 8 * (fq & 1); \
            dst[0] = *(const f32x4*)cp_; dst[1] = *(const f32x4*)(cp_ + 4); dst[2] = *(const f32x4*)sp_; dst[3] = *(const f32x4*)(sp_ + 4); } while (0)
        if (rope) MLA_CS(cs[0], 0);
        float rl[2][4];
#pragma unroll
        for (int ai = 0; ai < 2; ++ai)
#pragma unroll
            for (int m = 0; m < 4; ++m) { const f32x4 p = lp[ai][m];
                rl[ai][m] = __builtin_amdgcn_rsqf(((p[0] + p[1]) + (p[2] + p[3])) * (1.0f / 256.0f) + EPS); float ss = 0.f;
#pragma unroll
                for (int bj = 0; bj < 2; ++bj)
#pragma unroll
                    for (int n = 0; n < 2; ++n) { const f32x4 x = acc[ai][bj][m][n]; ss += (x[0] * x[0] + x[1] * x[1]) + (x[2] * x[2] + x[3] * x[3]); }
                ss += __shfl_xor(ss, 16); ss += __shfl_xor(ss, 32);
                if (fq == 0) P[(ai * HALF + wr * 64 + m * 16 + fr) * 4 + wc] = ss * rl[ai][m] * rl[ai][m]; }
        asm volatile("s_waitcnt lgkmcnt(0)" ::: "memory"); __builtin_amdgcn_s_barrier(); asm volatile("" ::: "memory");
#pragma unroll
        for (int i = 0; i < 8; ++i) { const int ai = i >> 2, m = i & 3; const int row = row0 + ai * HALF + m * 16; const LAS float* pr = P + (ai * HALF + wr * 64 + m * 16 + fr) * 4 + (wc & 2);
            if (rope && i < 7) MLA_CS(cs[(i + 1) & 1], i + 1);
            const float rs = rl[ai][m] * __builtin_amdgcn_rsqf((pr[0] + pr[1]) * (1.0f / 96.0f) + EPS);
            f16* qo = QB + (size_t)row * 384 + 96 * head;
            if (!rope) {
#pragma unroll
                for (int bj = 0; bj < 2; ++bj) *(u32x4*)(qo + 32 * bj + 8 * fq) = pack8(acc[ai][bj][m][0] * rs * g0[bj], acc[ai][bj][m][1] * rs * g1[bj]);
            } else {
                const f32x4 c0 = cs[i & 1][0], c1 = cs[i & 1][1], s0 = cs[i & 1][2], s1 = cs[i & 1][3];
                const f32x4 b0 = acc[ai][0][m][0] * rs * g0[0], b1 = acc[ai][0][m][1] * rs * g1[0]; f32x4 r0, r1;
#pragma unroll
                for (int e = 0; e < 4; ++e) { const float o0 = __shfl_xor(b0[e], 32), o1 = __shfl_xor(b1[e], 32);
                    r0[e] = (fq < 2) ? (b0[e] * c0[e] - o0 * s0[e]) : (o0 * s0[e] + b0[e] * c0[e]);
                    r1[e] = (fq < 2) ? (b1[e] * c1[e] - o1 * s1[e]) : (o1 * s1[e] + b1[e] * c1[e]); }
                *(u32x4*)(qo + 64 + 8 * fq) = pack8(r0, r1);
            } }
    }
};
struct EpiMlaKV {
    static constexpr bool PERM = true, AFTER_DRAIN = true;
    f16* KB; f16* VB; const f16* HB; const float* LSS; const float* gk; const float* ct; const float* st;
    __device__ __forceinline__ void fused(f32x4 (&acc)[2][2][4][2], const Unit& u, int wr, int wc, LAS unsigned char* lds) const {
        int tid_ = threadIdx.x; asm volatile("" : "+v"(tid_)); const int lane = tid_ & 63, fr = lane & 15, fq = lane >> 4;
        const int row0 = u.pm * BM + wr * 64 + fr, head = 2 * u.pn + (wc >> 1); const bool isv = (wc & 1) != 0;
        f32x2 lp[2][4];
#pragma unroll
        for (int ai = 0; ai < 2; ++ai)
#pragma unroll
            for (int m = 0; m < 4; ++m) lp[ai][m] = *(const f32x2*)(LSS + (size_t)(row0 + ai * HALF + m * 16) * 4);
        f32x4 g0[2], g1[2], gr0, gr1;
        if (!isv) {
#pragma unroll
            for (int bj = 0; bj < 2; ++bj) { g0[bj] = *(const f32x4*)(gk + 32 * bj + 8 * fq); g1[bj] = *(const f32x4*)(gk + 32 * bj + 8 * fq + 4); }
            gr0 = *(const f32x4*)(gk + 64 + 8 * fq); gr1 = *(const f32x4*)(gk + 64 + 8 * fq + 4); }
        f32x4 cs[2][4]; h8 krv[2];
#define MLA_KR(I) (*(const h8*)(HB + (size_t)(row0 + ((I) >> 2) * HALF + ((I) & 3) * 16) * HBP + C_KR + 8 * fq))
        if (!isv) { MLA_CS(cs[0], 0); krv[0] = MLA_KR(0); }
#pragma unroll
        for (int i = 0; i < 8; ++i) { const int ai = i >> 2, m = i & 3; const int row = row0 + ai * HALF + m * 16; const f32x2 p = lp[ai][m];
            const float rk = __builtin_amdgcn_rsqf((p[0] + p[1]) * (1.0f / 128.0f) + EPS);
            if (isv) {
                f16* vo = VB + (size_t)row * 256 + 64 * head;
#pragma unroll
                for (int bj = 0; bj < 2; ++bj) *(u32x4*)(vo + 32 * bj + 8 * fq) = pack8(acc[ai][bj][m][0] * rk, acc[ai][bj][m][1] * rk);
            } else {
                if (i < 7) { MLA_CS(cs[(i + 1) & 1], i + 1); krv[(i + 1) & 1] = MLA_KR(i + 1); }
                const h8 krh = krv[i & 1]; f32x4 k0, k1;
#pragma unroll
                for (int e = 0; e < 4; ++e) { k0[e] = (float)krh[e]; k1[e] = (float)krh[4 + e]; }
                float ss = 0.f, sk = 0.f;
#pragma unroll
                for (int bj = 0; bj < 2; ++bj)
#pragma unroll
                    for (int n = 0; n < 2; ++n) { const f32x4 x = acc[ai][bj][m][n]; ss += (x[0] * x[0] + x[1] * x[1]) + (x[2] * x[2] + x[3] * x[3]); }
#pragma unroll
                for (int e = 0; e < 4; ++e) sk += k0[e] * k0[e] + k1[e] * k1[e];
                ss = ss * rk * rk + sk; ss += __shfl_xor(ss, 16); ss += __shfl_xor(ss, 32);
                const float rs = __builtin_amdgcn_rsqf(ss * (1.0f / 96.0f) + EPS);
                f16* ko = KB + (size_t)row * 384 + 96 * head;
#pragma unroll
                for (int bj = 0; bj < 2; ++bj) *(u32x4*)(ko + 32 * bj + 8 * fq) = pack8(acc[ai][bj][m][0] * (rk * rs) * g0[bj], acc[ai][bj][m][1] * (rk * rs) * g1[bj]);
                const f32x4 c0 = cs[i & 1][0], c1 = cs[i & 1][1], s0 = cs[i & 1][2], s1 = cs[i & 1][3];
                const f32x4 b0 = k0 * rs * gr0, b1 = k1 * rs * gr1; f32x4 r0, r1;
#pragma unroll
                for (int e = 0; e < 4; ++e) { const float o0 = __shfl_xor(b0[e], 32), o1 = __shfl_xor(b1[e], 32);
                    r0[e] = (fq < 2) ? (b0[e] * c0[e] - o0 * s0[e]) : (o0 * s0[e] + b0[e] * c0[e]);
                    r1[e] = (fq < 2) ? (b1[e] * c1[e] - o1 * s1[e]) : (o1 * s1[e] + b1[e] * c1[e]); }
                *(u32x4*)(ko + 64 + 8 * fq) = pack8(r0, r1);
            } }
#undef MLA_KR
#undef MLA_CS
    }
};
template <class E_, class = void> struct epi_init_acc { static constexpr bool value = false; };
template <class E_> struct epi_init_acc<E_, decltype((void)E_::INIT_ACC)> { static constexpr bool value = E_::INIT_ACC; };
template <class Epi, bool ALIGN_EPI, bool SP2>
__device__ __forceinline__ void gemm_phase(LAS unsigned char* lds, const Gemm g, const StaticOrder& S, const Epi& E) {
    int tid_ = threadIdx.x; asm volatile("" : "+v"(tid_));
    const int tid = tid_, wid = __builtin_amdgcn_readfirstlane(tid >> 6), lane = tid & 63, wr = wid >> 2, wc = wid & 3, fr = lane & 15, fq = lane >> 4;
    const int K = g.K, nt = K / BK, lda = g.lda;
    unsigned voffA[2], voffB[2];
#pragma unroll
    for (int i = 0; i < 2; ++i) { int R, C; stage_rc(tid * 16 + i * 8192, R, C); const int Rb = Epi::PERM ? ((R & ~31) + perm32(R & 31)) : R;
        voffA[i] = (unsigned)(R * lda + C) * 2u; voffB[i] = (unsigned)(Rb * K + C) * 2u; }
    const size_t kstep = (size_t)(BK * 2);
    const size_t hstepA = (size_t)HALF * lda * 2, hstepB = (size_t)HALF * K * 2;
    const size_t tstepA = 2 * hstepA, tstepB = 2 * hstepB;
    const unsigned ldsw = (unsigned)wid * 1024u;
    const int aoff = lds_byte(wr * 64 + fr, fq * 8), boff = lds_byte(wc * 32 + fr, fq * 8);
#define PG8_SA(b, h) (((b) * 2 + (h)) * HTB)
#define PG8_SB(b, h) ((4 + (b) * 2 + (h)) * HTB)
#define PG8_STAGE(bufoff, gbase, voff) do { _Pragma("unroll") for (int _i = 0; _i < 2; ++_i) \
        __builtin_amdgcn_global_load_lds((const unsigned*)((const char*)(gbase) + (voff)[_i]), (LAS unsigned*)(lds + (bufoff) + ldsw + _i * 8192), 16, 0, 0); } while (0)
#define PG8_LDA(dst, b, h) do { _Pragma("unroll") for (int m = 0; m < 4; ++m) _Pragma("unroll") for (int k = 0; k < 2; ++k) dst[m][k] = *(const LAS h8*)(lds + PG8_SA(b, h) + aoff + m * 2048 + k * 1024); } while (0)
#define PG8_LDB(dst, b, h) do { _Pragma("unroll") for (int n = 0; n < 2; ++n) _Pragma("unroll") for (int k = 0; k < 2; ++k) dst[n][k] = *(const LAS h8*)(lds + PG8_SB(b, h) + boff + n * 2048 + k * 1024); } while (0)
#define PG8_MMA(ai, bj, At, Bt) do { __builtin_amdgcn_s_setprio(1); _Pragma("unroll") for (int m = 0; m < 4; ++m) _Pragma("unroll") for (int n = 0; n < 2; ++n) _Pragma("unroll") for (int k = 0; k < 2; ++k) \
        acc[ai][bj][m][n] = __builtin_amdgcn_mfma_f32_16x16x32_f16(Bt[n][k], At[m][k], acc[ai][bj][m][n], 0, 0, 0); __builtin_amdgcn_s_setprio(0); } while (0)
#define PG8_WAIT_V(n) asm volatile("s_waitcnt vmcnt(" #n ")" ::: "memory")
#define PG8_WAIT_L(n) asm volatile("s_waitcnt lgkmcnt(" #n ")" ::: "memory")
#define PG8_BAR __builtin_amdgcn_s_barrier()
#define PG8_SCHED __builtin_amdgcn_sched_barrier(0)
    Unit cur, nxt; int ui = 0;
    if (!S.next(0, cur)) return;
    f32x4 acc[2][2][4][2];
    if constexpr (!epi_init_acc<Epi>::value) {
#pragma unroll
    for (int a = 0; a < 2; ++a)
#pragma unroll
        for (int b = 0; b < 2; ++b)
#pragma unroll
            for (int m = 0; m < 4; ++m)
#pragma unroll
                for (int n = 0; n < 2; ++n) acc[a][b][m][n] = (f32x4){0.f, 0.f, 0.f, 0.f};
    }
    h8 At[4][2], B0[2][2], B1[2][2];
    const char* cA = (const char*)g.A + (size_t)cur.pm * tstepA; const char* cB = (const char*)g.Bt + (size_t)cur.pn * tstepB;
    if constexpr (SP2) {
        PG8_STAGE(PG8_SB(0, 0), cB, voffB); PG8_STAGE(PG8_SB(0, 1), cB + hstepB, voffB); PG8_STAGE(PG8_SA(0, 0), cA, voffA); PG8_STAGE(PG8_SA(0, 1), cA + hstepA, voffA);
        if constexpr (epi_init_acc<Epi>::value) { E.init(acc, cur, wr, wc); PG8_WAIT_V(0); if (wr == 1) PG8_BAR; PG8_BAR; }
        else { if (wr == 1) PG8_BAR; PG8_WAIT_V(2); PG8_BAR; }
        PG8_STAGE(PG8_SB(1, 0), cB + kstep, voffB); PG8_STAGE(PG8_SA(1, 0), cA + kstep, voffA); PG8_STAGE(PG8_SB(1, 1), cB + hstepB + kstep, voffB);
        PG8_WAIT_V(6); PG8_BAR;
    } else {
        PG8_STAGE(PG8_SB(0, 0), cB, voffB); PG8_STAGE(PG8_SA(0, 0), cA, voffA); PG8_STAGE(PG8_SB(0, 1), cB + hstepB, voffB); PG8_STAGE(PG8_SA(0, 1), cA + hstepA, voffA);
        if (wr == 1) PG8_BAR;
        PG8_WAIT_V(4); PG8_BAR;
        PG8_STAGE(PG8_SB(1, 0), cB + kstep, voffB); PG8_STAGE(PG8_SA(1, 0), cA + kstep, voffA); PG8_STAGE(PG8_SB(1, 1), cB + hstepB + kstep, voffB);
        PG8_WAIT_V(6); PG8_BAR;
    }
    for (;;) {
        const bool has_next = S.next(ui + 1, nxt);
        const char* nA = has_next ? (const char*)g.A + (size_t)nxt.pm * tstepA : cA; const char* nB = has_next ? (const char*)g.Bt + (size_t)nxt.pn * tstepB : cB;
#pragma nounroll
        for (int t = 0; t < nt; t += 2) {
            const bool last = (t == nt - 2);
            const char* a1 = cA + (size_t)(t + 1) * kstep;
            const char* a2 = last ? nA : cA + (size_t)(t + 2) * kstep; const char* b2 = last ? nB : cB + (size_t)(t + 2) * kstep;
            const char* a3 = a2 + kstep; const char* b3 = b2 + kstep;
            if constexpr (SP2) {
            PG8_LDB(B0, 0, 0); PG8_LDB(B1, 0, 1); PG8_SCHED; PG8_LDA(At, 0, 0); PG8_STAGE(PG8_SA(1, 1), a1 + hstepA, voffA);
            PG8_WAIT_V(8); PG8_WAIT_L(0); PG8_BAR; PG8_MMA(0, 0, At, B0); PG8_MMA(0, 1, At, B1); PG8_BAR; PG8_SCHED;
            PG8_LDA(At, 0, 1); PG8_STAGE(PG8_SB(0, 0), b2, voffB); PG8_STAGE(PG8_SB(0, 1), b2 + hstepB, voffB); PG8_STAGE(PG8_SA(0, 0), a2, voffA);
            PG8_WAIT_V(8); PG8_WAIT_L(0); PG8_BAR; PG8_MMA(1, 0, At, B0); PG8_MMA(1, 1, At, B1); PG8_BAR; PG8_SCHED;
            PG8_LDB(B0, 1, 0); PG8_LDB(B1, 1, 1); PG8_SCHED; PG8_LDA(At, 1, 0); PG8_STAGE(PG8_SA(0, 1), a2 + hstepA, voffA);
            PG8_WAIT_V(8); PG8_WAIT_L(0); PG8_BAR; PG8_MMA(0, 0, At, B0); PG8_MMA(0, 1, At, B1); PG8_BAR; PG8_SCHED;
            PG8_LDA(At, 1, 1); PG8_STAGE(PG8_SB(1, 0), b3, voffB); PG8_STAGE(PG8_SB(1, 1), b3 + hstepB, voffB); PG8_STAGE(PG8_SA(1, 0), a3, voffA);
            PG8_WAIT_V(8); PG8_WAIT_L(0); PG8_BAR; PG8_MMA(1, 0, At, B0); PG8_MMA(1, 1, At, B1); PG8_BAR; PG8_SCHED;
            } else {
            PG8_LDB(B0, 0, 0); PG8_SCHED; PG8_LDA(At, 0, 0); PG8_STAGE(PG8_SA(1, 1), a1 + hstepA, voffA);
            PG8_WAIT_L(8); PG8_BAR; PG8_WAIT_L(0); PG8_MMA(0, 0, At, B0); PG8_BAR; PG8_SCHED;
            PG8_LDB(B1, 0, 1); PG8_STAGE(PG8_SB(0, 0), b2, voffB);
            PG8_BAR; PG8_WAIT_L(0); PG8_MMA(0, 1, At, B1); PG8_BAR;
            PG8_LDA(At, 0, 1); PG8_STAGE(PG8_SA(0, 0), a2, voffA);
            PG8_BAR; PG8_WAIT_L(0); PG8_MMA(1, 0, At, B0); PG8_BAR; PG8_SCHED;
            PG8_STAGE(PG8_SB(0, 1), b2 + hstepB, voffB);
            PG8_WAIT_V(6); PG8_BAR; PG8_MMA(1, 1, At, B1); PG8_BAR;
            PG8_LDB(B0, 1, 0); PG8_SCHED; PG8_LDA(At, 1, 0); PG8_STAGE(PG8_SA(0, 1), a2 + hstepA, voffA);
            PG8_WAIT_L(8); PG8_BAR; PG8_WAIT_L(0); PG8_MMA(0, 0, At, B0); PG8_BAR; PG8_SCHED;
            PG8_LDB(B1, 1, 1); PG8_STAGE(PG8_SB(1, 0), b3, voffB);
            PG8_BAR; PG8_WAIT_L(0); PG8_MMA(0, 1, At, B1); PG8_BAR;
            PG8_LDA(At, 1, 1); PG8_STAGE(PG8_SA(1, 0), a3, voffA);
            PG8_BAR; PG8_WAIT_L(0); PG8_MMA(1, 0, At, B0); PG8_BAR; PG8_SCHED;
            PG8_STAGE(PG8_SB(1, 1), b3 + hstepB, voffB);
            PG8_WAIT_V(6); PG8_BAR; PG8_MMA(1, 1, At, B1); PG8_BAR;
            }
        }
        if constexpr (ALIGN_EPI) { if (wr == 0) PG8_BAR; }
        if constexpr (!Epi::AFTER_DRAIN) E(acc, cur, wr, wc);
        if (!has_next) break;
#pragma unroll
        for (int a = 0; a < 2; ++a)
#pragma unroll
            for (int b = 0; b < 2; ++b)
#pragma unroll
                for (int m = 0; m < 4; ++m)
#pragma unroll
                    for (int n = 0; n < 2; ++n) acc[a][b][m][n] = (f32x4){0.f, 0.f, 0.f, 0.f};
        cur = nxt; cA = nA; cB = nB; ++ui;
        if constexpr (ALIGN_EPI) { if (wr == 1) PG8_BAR; }
    }
    PG8_WAIT_V(0);
    if constexpr (!ALIGN_EPI) { if (wr == 0) PG8_BAR; }
    PG8_BAR;
    if constexpr (Epi::AFTER_DRAIN) E.fused(acc, cur, wr, wc, lds);
#undef PG8_SA
#undef PG8_SB
#undef PG8_STAGE
#undef PG8_LDA
#undef PG8_LDB
#undef PG8_MMA
#undef PG8_WAIT_V
#undef PG8_WAIT_L
#undef PG8_BAR
#undef PG8_SCHED
}
}

constexpr int NWAVES = 8;
constexpr int LDS_BYTES = 147456;
#define LDS_WAIT() asm volatile("s_waitcnt lgkmcnt(0)" ::: "memory")
#define VM_WAIT() asm volatile("s_waitcnt vmcnt(0)" ::: "memory")

struct Args { const float* in[21]; float* out; unsigned char* ws; int ph_lo, ph_hi, li, pad; };
enum { I_X = 0, I_ANG, I_WIN, I_MQG, I_MKG, I_QLG, I_KVLG, I_WUQ, I_WUKV, I_BQG, I_BKG, I_CQG, I_CKG, I_DQG, I_DKG, I_SINK, I_GOG, I_WO, I_MNG, I_WUP, I_WDOWN };

struct Frame {
    LAS unsigned char* lds;
    int vcu, G;
    float* out; unsigned char* ws;
};
__device__ __forceinline__ int lane_id() { return threadIdx.x & 63; }
__device__ __forceinline__ int wave_id() { return __builtin_amdgcn_readfirstlane(threadIdx.x >> 6); }
__device__ __forceinline__ float wave_sum(float v) {
#pragma unroll
    for (int o = 1; o < 64; o <<= 1) v += __shfl_xor(v, o);
    return v;
}
__device__ __forceinline__ unsigned pk2h(float lo, float hi) { return __builtin_bit_cast(unsigned, __builtin_convertvector((f32x2){lo, hi}, h2)); }
__device__ __forceinline__ f16* wt_ptr(const Frame& F, int l, size_t off) { return (f16*)(F.ws + WS_W + (size_t)l * W_LAYER + off); }

__device__ __forceinline__ void sincos_d(double a, double& c, double& s) {
    const double k = __builtin_rint(a * 0.63661977236758134308);
    const double r = (a - k * 1.57079632679489655800) - k * 6.12323399573676603587e-17;
    const double r2 = r * r;
    const double sp = r * (1.0 + r2 * (-1.0 / 6 + r2 * (1.0 / 120 + r2 * (-1.0 / 5040 + r2 * (1.0 / 362880 + r2 * (-1.0 / 39916800 + r2 * (1.0 / 6227020800.0)))))));
    const double cp = 1.0 + r2 * (-0.5 + r2 * (1.0 / 24 + r2 * (-1.0 / 720 + r2 * (1.0 / 40320 + r2 * (-1.0 / 3628800 + r2 * (1.0 / 479001600.0))))));
    const int q = (int)((long long)k & 3);
    s = (q == 0) ? sp : (q == 1) ? cp : (q == 2) ? -sp : -cp;
    c = (q == 0) ? cp : (q == 1) ? -sp : (q == 2) ? -cp : sp;
}
__device__ __forceinline__ void tr_item(const float* W, int N, int n0, int k0, f16* WT, int ldk, int drow0, LAS float* scr, int lane, const float* gk = nullptr) {
#pragma unroll
    for (int i = 0; i < 32; ++i) { const int kk = 2 * i + (lane >> 5); float v = (n0 >= 0) ? W[(size_t)(k0 + kk) * N + n0 + (lane & 31)] : 0.f; if (gk) v *= gk[k0 + kk]; scr[kk * 33 + (lane & 31)] = v; }
    LDS_WAIT(); asm volatile("" ::: "memory");
    const int c = lane & 7;
#pragma unroll
    for (int j = 0; j < 4; ++j) { const int n = (lane >> 3) + 8 * j; const LAS float* s = scr + (8 * c) * 33 + n;
        u32x4 o; o.x = pk2h(s[0 * 33], s[1 * 33]); o.y = pk2h(s[2 * 33], s[3 * 33]); o.z = pk2h(s[4 * 33], s[5 * 33]); o.w = pk2h(s[6 * 33], s[7 * 33]);
        *(u32x4*)(WT + (size_t)(drow0 + n) * ldk + k0 + 8 * c) = o; }
    LDS_WAIT(); asm volatile("" ::: "memory");
}
__device__ __forceinline__ void tr_item64(const float* W, int N, int srcA, int srcB, int k0, f16* WT, int ldk, int drowA, int drowB, LAS float* scr, int lane, const float* gk) {
    const int r4 = lane >> 4, c4 = lane & 15; const int src = (c4 >> 3) ? srcB : srcA;
#pragma unroll
    for (int i = 0; i < 16; ++i) { const int k = 4 * i + r4; f32x4 v = {0.f, 0.f, 0.f, 0.f};
        if (src >= 0) v = *(const f32x4*)(W + (size_t)(k0 + k) * N + src + 4 * (c4 & 7));
        if (gk) v = v * gk[k0 + k];
        *(LAS f32x4*)(scr + k * 68 + ((4 * c4 + 4 * (k >> 3)) & 63)) = v; }
    LDS_WAIT(); asm volatile("" ::: "memory");
    const int c = lane & 7;
#pragma unroll
    for (int j = 0; j < 8; ++j) { const int n = (lane >> 3) + 8 * j; const LAS float* sp = scr + (8 * c) * 68 + ((n + 4 * c) & 63);
        u32x4 o; o.x = pk2h(sp[0 * 68], sp[1 * 68]); o.y = pk2h(sp[2 * 68], sp[3 * 68]); o.z = pk2h(sp[4 * 68], sp[5 * 68]); o.w = pk2h(sp[6 * 68], sp[7 * 68]);
        const int row = (n < 32) ? (drowA + n) : (drowB + n - 32);
        *(u32x4*)(WT + (size_t)row * ldk + k0 + 8 * c) = o; }
    LDS_WAIT(); asm volatile("" ::: "memory");
}
__device__ __forceinline__ void x_row_to_f16(const float* xrow, f16* orow, float* rsp, int lane) {
    const f32x4* xr = (const f32x4*)xrow + lane;
    f32x4 v[4]; float s = 0.f;
#pragma unroll
    for (int j = 0; j < 4; ++j) { v[j] = xr[64 * j]; s += (v[j].x * v[j].x + v[j].y * v[j].y) + (v[j].z * v[j].z + v[j].w * v[j].w); }
    const float tot = wave_sum(s);
    if (lane == 0) *rsp = __builtin_amdgcn_rsqf(tot * (1.0f / DM) + EPS);
    u32x2* o8 = (u32x2*)orow + lane;
#pragma unroll
    for (int j = 0; j < 4; ++j) { u32x2 w; w.x = pk2h(v[j].x, v[j].y); w.y = pk2h(v[j].z, v[j].w); st8(o8 + 64 * j, w); }
}
namespace cv { constexpr int I_IN = 16 * 40, I_O = 16 * 16, I_UP = 16 * 64, I_DN = 64 * 16, I_UQ = 4 * 8, I_UKV = 2 * 8; constexpr int PER_L = I_IN + I_O + I_UP + I_DN + I_UQ + I_UKV;
    constexpr int URGENT0 = I_IN, DEFER0 = I_O + I_UP + I_DN, NDEFER = DEFER0 + PER_L; }
__device__ __forceinline__ void convert_subitem(Frame& F, const Args& args, int l, int r, LAS float* scr, int lane) {
    using namespace cv;
    if (r < I_IN) { const int kb = r / 40, g = r % 40, pn = g >> 2, wc = g & 3; const int c0 = 256 * pn + 64 * wc, c1 = c0 + 32;
        const int ocA = c0 < 1184 ? c0 : (c0 < 1280 ? -1 : c0 - 96), ocB = c1 < 1184 ? c1 : (c1 < 1280 ? -1 : c1 - 96);
        tr_item64(args.in[I_WIN] + (size_t)l * DM * NIN, NIN, ocA, ocB, 64 * kb, wt_ptr(F, l, WO_IN), DM, 256 * pn + 32 * wc, 256 * pn + 128 + 32 * wc, scr, lane, args.in[I_ANG] + l * DM); return; } r -= I_IN;
    if (r < I_O) { const int kb = r / 16, nb = r % 16; tr_item64(args.in[I_WO] + (size_t)l * DM * DM, DM, 64 * nb, 64 * nb + 32, 64 * kb, wt_ptr(F, l, WO_O), DM, 64 * nb, 64 * nb + 32, scr, lane, nullptr); return; } r -= I_O;
    if (r < I_UP) { const int kb = r / 64, nb = r % 64; tr_item64(args.in[I_WUP] + (size_t)l * DM * DFF, DFF, 64 * nb, 64 * nb + 32, 64 * kb, wt_ptr(F, l, WO_UP), DM, 64 * nb, 64 * nb + 32, scr, lane, args.in[I_MNG] + l * DM); return; } r -= I_UP;
    if (r < I_DN) { const int kb = r / 16, nb = r % 16; tr_item64(args.in[I_WDOWN] + (size_t)l * DFF * DM, DM, 64 * nb, 64 * nb + 32, 64 * kb, wt_ptr(F, l, WO_DOWN), DFF, 64 * nb, 64 * nb + 32, scr, lane, nullptr); return; } r -= I_DN;
    if (r < I_UQ) { const int kb = r / 8, g = r % 8, pn = g >> 2, wc = g & 3, hd = 2 * pn + (wc >> 1); const bool rope = (wc & 1) != 0;
        tr_item64(args.in[I_WUQ] + (size_t)l * 256 * 384, 384, rope ? 96 * hd + 64 : 96 * hd, rope ? -1 : 96 * hd + 32, 64 * kb, wt_ptr(F, l, WO_UQ), 256, 256 * pn + 32 * wc, 256 * pn + 128 + 32 * wc, scr, lane, args.in[I_QLG] + l * 256); return; } r -= I_UQ;
    { const int kb = r / 8, g = r % 8, pn = g >> 2, wc = g & 3, hd = 2 * pn + (wc >> 1); const int c0 = 128 * hd + ((wc & 1) ? 64 : 0);
        tr_item64(args.in[I_WUKV] + (size_t)l * 128 * 512, 512, c0, c0 + 32, 64 * kb, wt_ptr(F, l, WO_UKV), 256, 256 * pn + 32 * wc, 256 * pn + 128 + 32 * wc, scr, lane, args.in[I_KVLG] + l * 128); }
}
__device__ __forceinline__ void phase_prologue(Frame& F, const Args& args) {
    LAS float* scr = (LAS float*)(F.lds + wave_id() * 17408);
    const int gw = F.vcu * NWAVES + wave_id(), NGW = F.G * NWAVES;
    for (int it = gw; it < cv::URGENT0 + cv::I_UQ + cv::I_UKV; it += NGW) convert_subitem(F, args, 0, it < cv::URGENT0 ? it : (cv::PER_L - cv::I_UQ - cv::I_UKV) + (it - cv::URGENT0), scr, lane_id());
    { const int gt = (F.vcu * NWAVES + wave_id()) * 64 + lane_id(), NGT = NGW * 64; const u32x4 z = {0u, 0u, 0u, 0u};
      for (int i = gt; i < DEPTH * 512 * 16; i += NGT) { const int l = i / (512 * 16), rr = (i / 16) % 512, ch = i % 16; *(u32x4*)(wt_ptr(F, l, WO_UKV) + (size_t)rr * 256 + 128 + 8 * ch) = z; }
      for (int i = gt; i < DEPTH * 2560; i += NGT) { const int l = i / 2560, pn = (i % 2560) / 256, d = i % 64, hh = (i % 256) / 64; float v = 0.f; float* gt_ = (float*)wt_ptr(F, l, WO_GT) - l * 2560;
          if (pn == 0) v = args.in[I_MQG][l * 64 + d] * C2_64; else if (pn == 1) v = args.in[I_MKG][l * 64 + d]; else if (pn == 5) v = args.in[I_CQG][l * 64 + d] * C2_64;
          else if (pn == 6) v = args.in[I_CKG][l * 64 + d]; else if (pn == 8) v = args.in[I_DQG][l * 64 + d] * C2_64; else if (pn == 9 && hh < 2) v = args.in[I_DKG][l * 64 + d];
          gt_[i] = v; }
      float* ct = (float*)(F.ws + WS_ROPE); float* st = ct + SEQ * 16;
      for (int i = gt; i < SEQ * 16; i += NGT) { const int pos = i / 16, j = i % 16; double invd = 1.0; for (int q = 0; q < j; ++q) invd *= 0.56234132519034908;
          const float ang = (float)pos * (float)invd; double cs, sn; sincos_d((double)ang, cs, sn); ct[i] = (float)cs; st[i] = (float)sn; }
    }
    { f16* X16 = (f16*)(F.ws + WS_XN); float* RS = (float*)(F.ws + WS_RS);
      const int lane = lane_id(); f32x4 v[4], w[4]; int m = gw;
      if (m < T) {
#pragma unroll
          for (int jj = 0; jj < 4; ++jj) v[jj] = ((const f32x4*)(args.in[I_X] + (size_t)m * DM))[lane + 64 * jj]; }
      while (m < T) { const int nx = m + NGW;
#pragma unroll
          for (int jj = 0; jj < 4; ++jj) w[jj] = v[jj];
          if (nx < T) {
#pragma unroll
              for (int jj = 0; jj < 4; ++jj) v[jj] = ((const f32x4*)(args.in[I_X] + (size_t)nx * DM))[lane + 64 * jj]; }
          float ssum = 0.f;
#pragma unroll
          for (int jj = 0; jj < 4; ++jj) ssum += (w[jj].x * w[jj].x + w[jj].y * w[jj].y) + (w[jj].z * w[jj].z + w[jj].w * w[jj].w);
          const float tot = wave_sum(ssum);
          if (lane == 0) *(f32x4*)(RS + (size_t)m * 4) = (f32x4){tot, 0.f, 0.f, 0.f};
          u32x2* o8 = (u32x2*)(X16 + (size_t)m * DM) + lane;
#pragma unroll
          for (int jj = 0; jj < 4; ++jj) { u32x2 ww; ww.x = pk2h(w[jj].x, w[jj].y); ww.y = pk2h(w[jj].z, w[jj].w); o8[64 * jj] = ww; }
          m = nx; } }
}

__device__ __forceinline__ float half_sum(float v) { v += __shfl_xor(v, 1); v += __shfl_xor(v, 2); v += __shfl_xor(v, 4); v += __shfl_xor(v, 8); v += __shfl_xor(v, 16); return v; }
__device__ __forceinline__ void phase_mla_post(Frame& F, const Args& args, int l, int gw_, int NGW_, int tok0, int ntok, int sel_cu) {
    const int gw = F.vcu * NWAVES + wave_id(), NGW = F.G * NWAVES, lane = lane_id(), hf = lane >> 5, j = lane & 31;
    const f16* HB = (const f16*)(F.ws + WS_HB); const f16* QU = (const f16*)(F.ws + WS_QU); const f16* KVU = (const f16*)(F.ws + WS_KVU);
    f16* QB = (f16*)(F.ws + WS_QB); f16* KB = (f16*)(F.ws + WS_KB); f16* VB = (f16*)(F.ws + WS_VB);
    const float* gq = args.in[I_BQG] + l * 96; const float* gk = args.in[I_BKG] + l * 96;
    const float* ct = (const float*)(F.ws + WS_ROPE); const float* st = ct + SEQ * 16;
    const float gq0 = gq[2 * j], gq1 = gq[2 * j + 1], gq2 = gq[64 + j], gk0 = gk[2 * j], gk1 = gk[2 * j + 1], gk2 = gk[64 + j];
    struct PostIn { h8 ql; h4 kl; float kr; h2 qn[4]; float qrp[4]; h2 kn[4], vn[4]; float c, sn; };
#define POST_LOAD(P, m2_) do { const int m_ = 2 * (m2_) + hf; const f16* hr_ = HB + (size_t)m_ * HBP; \
        P.ql = *(const h8*)(hr_ + C_QL + 8 * j); P.kl = *(const h4*)(hr_ + C_KVL + 4 * j); P.kr = (float)hr_[C_KR + j]; \
        const f16* qu_ = QU + (size_t)m_ * 512; const f16* kvu_ = KVU + (size_t)m_ * 512; \
        _Pragma("unroll") for (int h = 0; h < 4; ++h) { P.qn[h] = *(const h2*)(qu_ + 96 * h + 2 * j); P.qrp[h] = (float)qu_[96 * h + 64 + j]; P.kn[h] = *(const h2*)(kvu_ + 128 * h + 2 * j); P.vn[h] = *(const h2*)(kvu_ + 128 * h + 64 + 2 * j); } \
        const int pos_ = m_ % SEQ; P.c = ct[pos_ * 16 + (j & 15)]; P.sn = st[pos_ * 16 + (j & 15)]; } while (0)
    const int tokend = tok0 + ntok;
    PostIn cur; int m2 = tok0 + gw_;
    if (m2 < tokend) POST_LOAD(cur, m2);
    while (m2 < tokend) {
        const int nx = m2 + NGW_; PostIn nxt = cur;
        if (nx < tokend) POST_LOAD(nxt, nx);
        const int m = 2 * m2 + hf;
        const float kr = cur.kr, c = cur.c, sn = cur.sn;
        float sq = 0.f, sk = 0.f;
#pragma unroll
        for (int e = 0; e < 8; ++e) sq += (float)cur.ql[e] * (float)cur.ql[e];
#pragma unroll
        for (int e = 0; e < 4; ++e) sk += (float)cur.kl[e] * (float)cur.kl[e];
        const float rq = __builtin_amdgcn_rsqf(half_sum(sq) * (1.0f / 256.0f) + EPS), rk = __builtin_amdgcn_rsqf(half_sum(sk) * (1.0f / 128.0f) + EPS);
        f16* qo = QB + (size_t)m * 384; f16* ko = KB + (size_t)m * 384; f16* vo = VB + (size_t)m * 256;
#pragma unroll
        for (int h = 0; h < 4; ++h) {
            { const float a0 = (float)cur.qn[h][0] * rq, a1 = (float)cur.qn[h][1] * rq, b = cur.qrp[h] * rq;
              const float rs = __builtin_amdgcn_rsqf(half_sum(a0 * a0 + a1 * a1 + b * b) * (1.0f / 96.0f) + EPS);
              const float bn = b * rs * gq2; const float other = __shfl_xor(bn, 16);
              const float r = ((j & 16) == 0) ? (bn * c - other * sn) : (other * sn + bn * c);
              *(unsigned*)(qo + 96 * h + 2 * j) = pk2h(a0 * rs * gq0 * C2_96, a1 * rs * gq1 * C2_96); qo[96 * h + 64 + j] = (f16)(r * C2_96); }
            { const float k0 = (float)cur.kn[h][0] * rk, k1 = (float)cur.kn[h][1] * rk;
              const float rs = __builtin_amdgcn_rsqf(half_sum(k0 * k0 + k1 * k1 + kr * kr) * (1.0f / 96.0f) + EPS);
              const float bn = kr * rs * gk2; const float other = __shfl_xor(bn, 16);
              const float r = ((j & 16) == 0) ? (bn * c - other * sn) : (other * sn + bn * c);
              *(unsigned*)(ko + 96 * h + 2 * j) = pk2h(k0 * rs * gk0, k1 * rs * gk1); ko[96 * h + 64 + j] = (f16)r;
              *(unsigned*)(vo + 64 * h + 2 * j) = pk2h((float)cur.vn[h][0] * rk, (float)cur.vn[h][1] * rk); }
        }
        cur = nxt; m2 = nx;
    }
#undef POST_LOAD
    {
        const float* KM = (const float*)(F.ws + WS_KMP); unsigned* lcnt = (unsigned*)(F.ws + WS_CTL) + CW_LCNT + l * 256;
        unsigned short* lists = (unsigned short*)(F.ws + WS_LIST); float* paml = (float*)(F.ws + WS_PAML);
        LAS float* kms = (LAS float*)F.lds;
        if (sel_cu >= 0) for (int wi = sel_cu; wi < 8 * 16; wi += 128) { const int bh = wi & 7, cg = wi >> 3, b = bh >> 2, h = bh & 3; const int c = 8 * cg + wave_id(); const int t = 64 * c + lane, qblk = c >> 2; const size_t row = (size_t)b * SEQ + t;
            __syncthreads();
            for (int i = threadIdx.x; i < (2 * cg + 2) * 64; i += 512) { const float* kq = KM + ((size_t)(b * 32 + (i >> 6)) * 4 + h) * 256 + (i & 63); kms[i] = (kq[0] + kq[64]) + (kq[128] + kq[192]); }
            __syncthreads();
            float q[64];
            { const f16* qrow = HB + row * HBP + C_AQ + 64 * h;
#pragma unroll
              for (int cc = 0; cc < 8; ++cc) { const h8 v = *(const h8*)(qrow + 8 * cc);
#pragma unroll
                  for (int jj = 0; jj < 8; ++jj) q[8 * cc + jj] = (float)v[jj]; } }
            float v1 = -INFINITY, v2 = -INFINITY, v3 = -INFINITY; int i1 = -1, i2 = -1, i3 = -1;
            for (int jb = 0; jb < qblk; ++jb) { const LAS float* km = kms + 64 * jb;
                float g0 = 0.f, g1 = 0.f;
#pragma unroll
                for (int cc = 0; cc < 16; ++cc) { const f32x4 kv = *(const LAS f32x4*)(km + 4 * cc); g0 += q[4 * cc] * kv[0] + q[4 * cc + 2] * kv[2]; g1 += q[4 * cc + 1] * kv[1] + q[4 * cc + 3] * kv[3]; }
                const float g = g0 + g1;
                if (g > v1) { v3 = v2; i3 = i2; v2 = v1; i2 = i1; v1 = g; i1 = jb; } else if (g > v2) { v3 = v2; i3 = i2; v2 = g; i2 = jb; } else if (g > v3) { v3 = g; i3 = jb; } }
            unsigned selbits = 0u; if (i1 >= 0) selbits |= 1u << i1; if (i2 >= 0) selbits |= 1u << i2; if (i3 >= 0) selbits |= 1u << i3;
            const unsigned long long ltmask = (1ull << lane) - 1ull;
            unsigned mycount = 0u, rk1 = 0u, rk2 = 0u, rk3 = 0u;
            for (int jb = 0; jb < qblk; ++jb) { const unsigned long long bj = __ballot((selbits >> jb) & 1u);
                const unsigned rnk = (unsigned)__popcll(bj & ltmask);
                if (jb == i1) rk1 = rnk; if (jb == i2) rk2 = rnk; if (jb == i3) rk3 = rnk;
                if (lane == jb) mycount = (unsigned)__popcll(bj); }
            unsigned base = 0u;
            if (mycount) base = __hip_atomic_fetch_add(lcnt + bh * 32 + lane, mycount, __ATOMIC_RELAXED, __HIP_MEMORY_SCOPE_AGENT);
#pragma unroll
            for (int sl = 0; sl < 3; ++sl) { const int jb = (sl == 0) ? i1 : (sl == 1 ? i2 : i3); const unsigned rnk = (sl == 0) ? rk1 : (sl == 1 ? rk2 : rk3);
                const unsigned bs = (unsigned)__shfl((int)base, jb >= 0 ? jb : 0);
                if (jb >= 0) lists[(size_t)bh * LIST_STRIDE + 256 * (31 * jb - (jb * (jb - 1)) / 2) + bs + rnk] = (unsigned short)(t | (sl << 13));
                else *(f32x2*)(paml + (((size_t)sl * T + row) * 4 + h) * 2) = (f32x2){0.f, 0.f}; } }
    }
}
__device__ __forceinline__ void kmean_block(Frame& F, int bb) {
    const int lane = lane_id();
    const f16* HB = (const f16*)(F.ws + WS_HB); float* KM = (float*)(F.ws + WS_KMP);
#pragma unroll 1
    for (int i2 = 0; i2 < 2; ++i2) { const int it = bb * 16 + wave_id() * 2 + i2; const int h = (it >> 2) & 3, qr = it & 3;
        const f16* kp = HB + ((size_t)bb * 256 + qr * 64 + (lane >> 3)) * HBP + C_AK + 64 * h + 8 * (lane & 7);
        h8 v[8];
#pragma unroll
        for (int i = 0; i < 8; ++i) v[i] = *(const h8*)(kp + (size_t)(8 * i) * HBP);
        float acc8[8];
#pragma unroll
        for (int e = 0; e < 8; ++e) { float a = 0.f;
#pragma unroll
            for (int i = 0; i < 8; ++i) a += (float)v[i][e];
            a += __shfl_xor(a, 8); a += __shfl_xor(a, 16); a += __shfl_xor(a, 32); acc8[e] = a * (1.0f / 256.0f); }
        if (lane < 8) { float* o = KM + (size_t)it * 64 + 8 * lane; *(f32x4*)o = (f32x4){acc8[0], acc8[1], acc8[2], acc8[3]}; *(f32x4*)(o + 4) = (f32x4){acc8[4], acc8[5], acc8[6], acc8[7]}; } }
}
__device__ __forceinline__ void phase_kmean(Frame& F, int gw, int NGW) {
    const int lane = lane_id();
    const f16* HB = (const f16*)(F.ws + WS_HB); float* KM = (float*)(F.ws + WS_KMP);
    for (int it = gw; it < BATCH * 32 * 4 * 4; it += NGW) { const int bb = it >> 4, h = (it >> 2) & 3, qr = it & 3;
        const f16* kp = HB + ((size_t)bb * 256 + qr * 64 + (lane >> 3)) * HBP + C_AK + 64 * h + 8 * (lane & 7);
        h8 v[8];
#pragma unroll
        for (int i = 0; i < 8; ++i) v[i] = *(const h8*)(kp + (size_t)(8 * i) * HBP);
        float acc8[8];
#pragma unroll
        for (int e = 0; e < 8; ++e) { float a = 0.f;
#pragma unroll
            for (int i = 0; i < 8; ++i) a += (float)v[i][e];
            a += __shfl_xor(a, 8); a += __shfl_xor(a, 16); a += __shfl_xor(a, 32); acc8[e] = a * (1.0f / 256.0f); }
        if (lane < 8) { float* o = KM + (size_t)it * 64 + 8 * lane; *(f32x4*)o = (f32x4){acc8[0], acc8[1], acc8[2], acc8[3]}; *(f32x4*)(o + 4) = (f32x4){acc8[4], acc8[5], acc8[6], acc8[7]}; } }
}
__device__ __forceinline__ void phase_mix(Frame& F, const Args& args, int l) {
    const int gw = F.vcu * NWAVES + wave_id(), NGW = F.G * NWAVES, lane = lane_id();
    f16* OR = (f16*)(F.ws + WS_OR); const f16* CPO = (const f16*)((const unsigned char*)F.out + OUT_CPO); const float* CPML = (const float*)(F.ws + WS_CPML);
    const f16* PA01 = (const f16*)(F.ws + WS_PA01); const f16* PA2 = (const f16*)((const unsigned char*)F.out + OUT_PA2); const float* PAML = (const float*)(F.ws + WS_PAML);
    const float* gog = args.in[I_GOG] + l * 1024;
    const int grp = lane >> 4, cl = (lane & 15) * 16, h = cl >> 6;
    const bool isA = (grp == 0) && !(ATT_VALU & 1), isC = (grp == 2), plain = !isA && !isC;
    const f16* own = OR + lane * 16;
    const f16* sb[4]; int sst[4]; const float* mb_[4]; bool used[4];
#pragma unroll
    for (int p = 0; p < 4; ++p) { sb[p] = own; sst[p] = DM; mb_[p] = PAML; used[p] = false; }
    if (isA) { sb[0] = PA01 + cl; sb[1] = PA01 + (size_t)T * 256 + cl; sb[2] = PA2 + cl; sst[0] = sst[1] = sst[2] = 256;
#pragma unroll
        for (int p = 0; p < 4; ++p) { mb_[p] = PAML + ((size_t)p * T * 4 + h) * 2; used[p] = true; } }
    if (isC) {
#pragma unroll
        for (int p = 0; p < 3; ++p) { sb[p] = CPO + (size_t)p * T * 256 + cl; sst[p] = 256; mb_[p] = CPML + ((size_t)p * T * 4 + h) * 2; used[p] = true; } }
    float gg[16];
#pragma unroll
    for (int e = 0; e < 16; ++e) gg[e] = gog[lane * 16 + e];
    struct MixIn { h8 x[4][2]; f32x2 ml[4]; };
#define MIX_LOAD(I, m_) do { _Pragma("unroll") for (int p = 0; p < 4; ++p) { const f16* sp_ = sb[p] + (size_t)(m_) * sst[p]; I.x[p][0] = *(const h8*)sp_; I.x[p][1] = *(const h8*)(sp_ + 8); I.ml[p] = *(const f32x2*)(mb_[p] + (size_t)(m_) * 8); } } while (0)
    MixIn cur; int m = gw;
    if (m < T) MIX_LOAD(cur, m);
    while (m < T) {
        const int nx = m + NGW; MixIn nxt = cur;
        if (nx < T) MIX_LOAD(nxt, nx);
        float M = plain ? 0.f : -INFINITY;
#pragma unroll
        for (int p = 0; p < 4; ++p) if (used[p]) M = fmaxf(M, cur.ml[p].x);
        float w[4], den = 0.f;
#pragma unroll
        for (int p = 0; p < 4; ++p) { const float lp = used[p] ? cur.ml[p].y : ((plain && p == 0) ? 1.0f : 0.f); const float dp = used[p] ? cur.ml[p].x : M;
            w[p] = (lp > 0.f) ? exp2f(dp - M) * lp : 0.f; den += w[p]; }
        float v[16];
#pragma unroll
        for (int e = 0; e < 16; ++e) v[e] = 0.f;
#pragma unroll
        for (int p = 0; p < 4; ++p) { const bool ok = w[p] > 0.f;
#pragma unroll
            for (int e = 0; e < 8; ++e) { v[e] += ok ? w[p] * (float)cur.x[p][0][e] : 0.f; v[8 + e] += ok ? w[p] * (float)cur.x[p][1][e] : 0.f; } }
        const float inv = 1.0f / den;
        float ss = 0.f;
#pragma unroll
        for (int e = 0; e < 16; ++e) { v[e] *= inv; ss += v[e] * v[e]; }
        ss += __shfl_xor(ss, 1); ss += __shfl_xor(ss, 2); ss += __shfl_xor(ss, 4); ss += __shfl_xor(ss, 8);
        const float rs = __builtin_amdgcn_rsqf(ss * (1.0f / 256.0f) + EPS);
        u32x4 w0, w1;
        w0.x = pk2h(v[0] * rs * gg[0], v[1] * rs * gg[1]); w0.y = pk2h(v[2] * rs * gg[2], v[3] * rs * gg[3]); w0.z = pk2h(v[4] * rs * gg[4], v[5] * rs * gg[5]); w0.w = pk2h(v[6] * rs * gg[6], v[7] * rs * gg[7]);
        w1.x = pk2h(v[8] * rs * gg[8], v[9] * rs * gg[9]); w1.y = pk2h(v[10] * rs * gg[10], v[11] * rs * gg[11]); w1.z = pk2h(v[12] * rs * gg[12], v[13] * rs * gg[13]); w1.w = pk2h(v[14] * rs * gg[14], v[15] * rs * gg[15]);
        *(u32x4*)(OR + (size_t)m * DM + lane * 16) = w0; *(u32x4*)(OR + (size_t)m * DM + lane * 16 + 8) = w1;
        cur = nxt; m = nx;
    }
#undef MIX_LOAD
}


namespace att {
typedef short s16x4 __attribute__((ext_vector_type(4)));
typedef float f32x16 __attribute__((ext_vector_type(16)));
constexpr int TILE_K = 12288, TILE_V = 8192, SLOT_K = 2 * TILE_K, SLOT_V = 2 * TILE_V;
constexpr int L_K = 0, L_V = 2 * SLOT_K, L_WS = L_V + 2 * SLOT_V, L_OST = L_WS + 8 * 256, L_FLAG = L_OST + 8 * 4096, L_END = L_FLAG + 64;
constexpr float THR = 8.0f, BIGM = 30000.0f;
struct AU {
    const f16 *q, *k, *v; f16* o; float* ml; const float* kmean;
    int qs, ks, vs, os, mls;
    int t_lo, t_hi, qb; float slope2, sink2;
    const unsigned short* list; int nrows, nnext, par, jblk, last, kvres; f16 *pa01, *pa2; float* paml; int h;
};
constexpr int L_ENT = L_END;
constexpr int L_END2 = L_ENT + 2048;
__device__ __forceinline__ int crow(int r, int hi) { return (r & 3) + 8 * (r >> 2) + 4 * hi; }
__device__ __forceinline__ void glds16(const void* gsrc, unsigned lds_dst) { unsigned keep;
    asm volatile("s_mov_b32 %0, m0\n\ts_mov_b32 m0, %2\n\ts_nop 0\n\tglobal_load_lds_dwordx4 %1, off\n\ts_mov_b32 m0, %0" : "=&s"(keep) : "v"(gsrc), "s"(lds_dst) : "memory"); }
__device__ __forceinline__ unsigned rfl(unsigned x) { return (unsigned)__builtin_amdgcn_readfirstlane((int)x); }
typedef short v4i16_t __attribute__((ext_vector_type(4)));
__device__ __forceinline__ s16x4 vtr(const LAS unsigned char* p) { return __builtin_bit_cast(s16x4, __builtin_amdgcn_ds_read_tr16_b64_v4i16((LAS v4i16_t*)p)); }
__device__ __forceinline__ unsigned pkh(float lo, float hi) { return __builtin_bit_cast(unsigned, __builtin_convertvector((f32x2){lo, hi}, h2)); }
__device__ __forceinline__ unsigned pk_hilo(float x) { const f16 h = (f16)x; const f16 l = (f16)((x - (float)h) * 1024.0f); return (unsigned)__builtin_bit_cast(unsigned short, h) | ((unsigned)__builtin_bit_cast(unsigned short, l) << 16); }
__device__ __forceinline__ unsigned pk_hilo64(float x) { const f16 h = (f16)x; const f16 l = (f16)((x - (float)h) * 1024.0f); const f16 h64 = (f16)((float)h * 64.0f), l64 = (f16)((float)l * 64.0f);
    return (unsigned)__builtin_bit_cast(unsigned short, h64) | ((unsigned)__builtin_bit_cast(unsigned short, l64) << 16); }
__device__ __forceinline__ float rowmax32(const f32x16& p0, const f32x16& p1) {
    float a = fmaxf(fmaxf(p0[0], p0[1]), p1[0]), b = fmaxf(fmaxf(p0[2], p0[3]), p1[1]); a = fmaxf(fmaxf(a, p1[2]), p1[3]);
#pragma unroll
    for (int r = 4; r < 16; r += 4) { a = fmaxf(fmaxf(a, p0[r]), p0[r + 1]); b = fmaxf(fmaxf(b, p0[r + 2]), p0[r + 3]); a = fmaxf(fmaxf(a, p1[r]), p1[r + 1]); b = fmaxf(fmaxf(b, p1[r + 2]), p1[r + 3]); }
    return fmaxf(a, b);
}
#define ATT_WAITBAR(N) asm volatile("s_waitcnt vmcnt(" #N ") lgkmcnt(0)\n\ts_barrier" ::: "memory")

template <int DQK, int MK, bool MOBA, bool SINK, bool PART, int W, bool GATH = false>
__device__ __forceinline__ void attn_unit(LAS unsigned char* lds, const AU& u, unsigned* qctr, unsigned& nxt) {
    constexpr int ND = DQK / 16; constexpr bool EXT = (DQK == 64);
    int tid_ = threadIdx.x; asm volatile("" : "+v"(tid_));
    const int tid = tid_, lane = tid & 63, r32 = lane & 31, hi = lane >> 5; const int wid = __builtin_amdgcn_readfirstlane(tid >> 6);
    const unsigned lds0 = (unsigned)(uintptr_t)lds;
    LAS float* wsf = (LAS float*)(lds + L_WS) + wid * 64;
    const int qi = 32 * wid + r32;
    LAS unsigned* ent = (LAS unsigned*)(lds + L_ENT) + (GATH ? 256 * u.par : 0);
    unsigned e_next = 0u;
    int tq_ = 0;
    if constexpr (GATH) {
        if (!u.kvres) {
            if (tid < 256) { unsigned e = (unsigned)u.list[tid < u.nrows ? tid : 0]; if (tid >= u.nrows) e |= 0x8000u; ent[tid] = e; }
            asm volatile("s_waitcnt vmcnt(0) lgkmcnt(0)\n\ts_barrier" ::: "memory"); }
        if (u.nnext > 0 && tid < 256) { e_next = (unsigned)u.list[256 + (tid < u.nnext ? tid : 0)]; if (tid >= u.nnext) e_next |= 0x8000u; }
        tq_ = (int)(ent[qi] & 0x1fffu);
    }
#define ATT_DMA1(t, kdst, vdst, XW) do { const long kk0_ = (long)(t) * 64; \
        glds16(u.k + (kk0_ + lane) * (long)u.ks + 8 * wid, rfl(lds0 + (kdst) + wid * 1024)); \
        if (DQK == 96 && (XW)) glds16(u.k + (kk0_ + lane) * (long)u.ks + 64 + 8 * (wid & 3), rfl(lds0 + (kdst) + (8 + (wid & 3)) * 1024)); \
        glds16(u.v + (kk0_ + 16 * (wid & 3) + (lane >> 2)) * (long)u.vs + 32 * (wid >> 2) + 8 * (lane & 3), rfl(lds0 + (vdst) + wid * 1024)); } while (0)
#define ATT_DMA(t, slot) do { ATT_DMA1((t), L_K + (slot) * SLOT_K, L_V + (slot) * SLOT_V, wid < 4); ATT_DMA1((t) + 1, L_K + (slot) * SLOT_K + TILE_K, L_V + (slot) * SLOT_V + TILE_V, wid >= 4); } while (0)
    if (!(GATH && u.kvres)) ATT_DMA(u.t_lo, 0);
    h8 qr[ND];
    { const f16* qrow = u.q + (long)(GATH ? tq_ : qi) * u.qs + 8 * hi;
#pragma unroll
      for (int d0 = 0; d0 < ND; ++d0) qr[d0] = *(const h8*)(qrow + 16 * d0);
#pragma unroll
      for (int d0 = 0; d0 < ND; ++d0) asm volatile("" : "+v"(qr[d0])); }
    unsigned selmask = 0u;
    if constexpr (MOBA) {
        LAS float* kms = (LAS float*)(lds + L_OST);
        for (int i = tid; i < u.qb * 64; i += 512) kms[i] = u.kmean[(size_t)(i >> 6) * 256 + (i & 63)];
        float qf[64];
        { const f16* qrow = u.q + (long)qi * u.qs;
#pragma unroll
          for (int c = 0; c < 8; ++c) { const h8 v = *(const h8*)(qrow + 8 * c);
#pragma unroll
              for (int j = 0; j < 8; ++j) qf[8 * c + j] = (float)v[j]; } }
        asm volatile("s_waitcnt lgkmcnt(0)\n\ts_barrier" ::: "memory");
        float v1 = -INFINITY, v2 = -INFINITY, v3 = -INFINITY; int i1 = -1, i2 = -1, i3 = -1;
        for (int j = 0; j < u.qb; ++j) {
            float g0 = 0.f, g1 = 0.f;
#pragma unroll
            for (int c = 0; c < 16; ++c) { const f32x4 kv = *(const LAS f32x4*)(kms + 64 * j + 4 * c); g0 += qf[4 * c] * kv[0] + qf[4 * c + 2] * kv[2]; g1 += qf[4 * c + 1] * kv[1] + qf[4 * c + 3] * kv[3]; }
            const float g = g0 + g1;
            if (g > v1) { v3 = v2; i3 = i2; v2 = v1; i2 = i1; v1 = g; i1 = j; } else if (g > v2) { v3 = v2; i3 = i2; v2 = g; i2 = j; } else if (g > v3) { v3 = g; i3 = j; }
        }
        if (i1 >= 0) selmask |= 1u << i1; if (i2 >= 0) selmask |= 1u << i2; if (i3 >= 0) selmask |= 1u << i3;
        selmask |= 1u << u.qb;
        asm volatile("s_waitcnt lgkmcnt(0)\n\ts_barrier" ::: "memory");
    }
    float dlt = 0.f, l_reg = 0.f; const float mh0 = EXT ? u.slope2 * (float)(GATH ? (tq_ - 256 * u.jblk) : qi) : 0.f;
    f32x16 o[2]; o[0] = f32x16{}; o[1] = f32x16{};
    u32x4 kx0 = {0u, 0u, 0u, 0u}, kx1 = {0u, 0u, 0u, 0u}, qx = {0u, 0u, 0u, 0u};
    if constexpr (EXT) {
        kx0.x = pkh((float)r32, (float)r32 * (1.0f / 1024.0f)); kx1.x = pkh((float)(r32 + 32), (float)(r32 + 32) * (1.0f / 1024.0f));
        kx0.z = kx1.z = pkh(-1.0f, -1.0f / 1024.0f);
        qx.x = hi ? 0u : pk_hilo(u.slope2); qx.y = hi ? 0u : pk_hilo64(u.slope2); qx.z = hi ? 0u : pk_hilo(mh0);
    }
    const LAS unsigned char* vbase = lds + L_V + ((lane >> 4) & 1) * 32 + (lane & 3) * 8 + (4 * hi + ((lane & 15) >> 2)) * 64;
    const LAS unsigned char* kbase = lds + L_K + hi * 1024 + r32 * 16;
    ATT_WAITBAR(0);
    int slot = 0; int cur_blk = -1000; bool rowsel = true;
    for (int t = u.t_lo; t < u.t_hi; t += 2) {
        const bool more = (t + 2 < u.t_hi);
        bool active = true;
        if constexpr (MK == 0) { if (t >= 0 && 64 * t > 32 * wid + 31) active = false; }
        else if constexpr (MK == 1) { if (64 * t > 32 * wid + 31 || 64 * t + 127 < 32 * wid - W) active = false; }
        if constexpr (MOBA) {
            const int blk = u.qb + (t >> 2);
            if (blk != cur_blk) { cur_blk = blk; rowsel = ((selmask >> blk) & 1u) != 0u;
                const float mh = rowsel ? (mh0 + dlt) : BIGM; qx.z = hi ? 0u : pk_hilo(mh); }
            if (!__any(rowsel)) active = false;
        }
        if (more && !(GATH && u.kvres) && (wid < 4 || !active)) ATT_DMA(t + 2, slot ^ 1);
        if (active) {
            const LAS unsigned char* Ks = kbase + slot * SLOT_K;
            f32x16 p0 = f32x16{}, p1 = f32x16{}, p2 = f32x16{}, p3 = f32x16{};
            constexpr int NBF = 2;
            constexpr int NBATCH = 2 * ND / NBF;
            h8 kc[2 * NBF], kn[2 * NBF];
#define ATT_KLOAD(dst, bi) do { const int tile_ = ((bi) * NBF) / ND, d0b_ = ((bi) * NBF) % ND; \
                _Pragma("unroll") for (int j = 0; j < NBF; ++j) { dst[2 * j] = *(const LAS h8*)(Ks + tile_ * TILE_K + (d0b_ + j) * 2048); dst[2 * j + 1] = *(const LAS h8*)(Ks + tile_ * TILE_K + (d0b_ + j) * 2048 + 512); } } while (0)
            ATT_KLOAD(kc, 0);
#pragma unroll
            for (int bi = 0; bi < NBATCH; ++bi) {
                if (bi + 1 < NBATCH) ATT_KLOAD(kn, bi + 1);
                __builtin_amdgcn_sched_barrier(0);
                const int tile_ = (bi * NBF) / ND, d0b_ = (bi * NBF) % ND;
#pragma unroll
                for (int j = 0; j < NBF; ++j) {
                    if (tile_ == 0) { p0 = __builtin_amdgcn_mfma_f32_32x32x16_f16(kc[2 * j], qr[d0b_ + j], p0, 0, 0, 0); p1 = __builtin_amdgcn_mfma_f32_32x32x16_f16(kc[2 * j + 1], qr[d0b_ + j], p1, 0, 0, 0); }
                    else            { p2 = __builtin_amdgcn_mfma_f32_32x32x16_f16(kc[2 * j], qr[d0b_ + j], p2, 0, 0, 0); p3 = __builtin_amdgcn_mfma_f32_32x32x16_f16(kc[2 * j + 1], qr[d0b_ + j], p3, 0, 0, 0); }
                }
                __builtin_amdgcn_sched_barrier(0);
#pragma unroll
                for (int j = 0; j < 2 * NBF; ++j) kc[j] = kn[j];
            }
#undef ATT_KLOAD
            if constexpr (EXT) { kx0.y = kx1.y = pkh((float)t, (float)t * (1.0f / 1024.0f));
                p0 = __builtin_amdgcn_mfma_f32_32x32x16_f16(__builtin_bit_cast(h8, kx0), __builtin_bit_cast(h8, qx), p0, 0, 0, 0);
                p1 = __builtin_amdgcn_mfma_f32_32x32x16_f16(__builtin_bit_cast(h8, kx1), __builtin_bit_cast(h8, qx), p1, 0, 0, 0);
                u32x4 ky0 = kx0, ky1 = kx1; ky0.y = ky1.y = pkh((float)(t + 1), (float)(t + 1) * (1.0f / 1024.0f));
                p2 = __builtin_amdgcn_mfma_f32_32x32x16_f16(__builtin_bit_cast(h8, ky0), __builtin_bit_cast(h8, qx), p2, 0, 0, 0);
                p3 = __builtin_amdgcn_mfma_f32_32x32x16_f16(__builtin_bit_cast(h8, ky1), __builtin_bit_cast(h8, qx), p3, 0, 0, 0); }
            else { if (__any(dlt != 0.f)) {
#pragma unroll
                for (int r = 0; r < 16; ++r) { p0[r] -= dlt; p1[r] -= dlt; p2[r] -= dlt; p3[r] -= dlt; } } }
            if (more && !(GATH && u.kvres) && wid >= 4) ATT_DMA(t + 2, slot ^ 1);
            if (wid >= 4) __builtin_amdgcn_s_setprio(1);
            if constexpr (MK == 0) { if (t + 1 >= 0) { const int kb = 64 * t + 4 * hi;
#pragma unroll
                for (int r = 0; r < 16; ++r) { const int kv = kb + (r & 3) + 8 * (r >> 2); if (kv > qi) p0[r] = -INFINITY; if (kv + 32 > qi) p1[r] = -INFINITY; if (kv + 64 > qi) p2[r] = -INFINITY; if (kv + 96 > qi) p3[r] = -INFINITY; } } }
            else if constexpr (MK == 1) { const int rb = qi - 64 * t - 4 * hi;
#pragma unroll
                for (int r = 0; r < 16; ++r) { const int rel = rb - ((r & 3) + 8 * (r >> 2)); if ((unsigned)rel > (unsigned)W) p0[r] = -INFINITY; if ((unsigned)(rel - 32) > (unsigned)W) p1[r] = -INFINITY;
                    if ((unsigned)(rel - 64) > (unsigned)W) p2[r] = -INFINITY; if ((unsigned)(rel - 96) > (unsigned)W) p3[r] = -INFINITY; } }
            float rm = fmaxf(rowmax32(p0, p1), rowmax32(p2, p3));
            { const auto rr = __builtin_amdgcn_permlane32_swap(__float_as_uint(rm), __float_as_uint(rm), false, false); rm = fmaxf(__uint_as_float(rr[0]), __uint_as_float(rr[1])); }
            if (__builtin_expect(__any(rm > THR), 0)) {
                const float dl = fmaxf(rm, 0.f); dlt += dl;
#pragma unroll
                for (int r = 0; r < 16; ++r) { p0[r] -= dl; p1[r] -= dl; p2[r] -= dl; p3[r] -= dl; }
                const float f = __builtin_amdgcn_exp2f(-dl); l_reg *= f;
                if (hi == 0) wsf[r32] = f;
                asm volatile("s_waitcnt lgkmcnt(0)" ::: "memory");
#pragma unroll
                for (int d_ = 0; d_ < 2; ++d_)
#pragma unroll
                    for (int r = 0; r < 16; ++r) o[d_][r] *= wsf[crow(r, hi)];
                if constexpr (EXT) { const float mh = (MOBA && !rowsel) ? BIGM : (mh0 + dlt); qx.z = hi ? 0u : pk_hilo(mh); }
            }
            const LAS unsigned char* Vs = vbase + slot * SLOT_V;
#define ATT_VLOAD(lo, hv, VOFF) do { _Pragma("unroll") for (int i_ = 0; i_ < 4; ++i_) { lo[i_] = vtr(Vs + (VOFF) + i_ * 1024); hv[i_] = vtr(Vs + (VOFF) + i_ * 1024 + 512); } } while (0)
#define ATT_VF(lo, hv, i) __builtin_bit_cast(h8, (short __attribute__((ext_vector_type(8)))){lo[i][0], lo[i][1], lo[i][2], lo[i][3], hv[i][0], hv[i][1], hv[i][2], hv[i][3]})
#define ATT_EXPPACK(PA, PB, W0, W1, W2, W3) do { \
            _Pragma("unroll") for (int r = 0; r < 16; ++r) { PA[r] = __builtin_amdgcn_exp2f(PA[r]); PB[r] = __builtin_amdgcn_exp2f(PB[r]); } \
            float sacc = 0.f; _Pragma("unroll") for (int r = 0; r < 16; ++r) sacc += PA[r] + PB[r]; \
            l_reg += sacc; \
            W0 = (u32x4){pkh(PA[0], PA[1]), pkh(PA[2], PA[3]), pkh(PA[4], PA[5]), pkh(PA[6], PA[7])}; \
            W1 = (u32x4){pkh(PA[8], PA[9]), pkh(PA[10], PA[11]), pkh(PA[12], PA[13]), pkh(PA[14], PA[15])}; \
            W2 = (u32x4){pkh(PB[0], PB[1]), pkh(PB[2], PB[3]), pkh(PB[4], PB[5]), pkh(PB[6], PB[7])}; \
            W3 = (u32x4){pkh(PB[8], PB[9]), pkh(PB[10], PB[11]), pkh(PB[12], PB[13]), pkh(PB[14], PB[15])}; } while (0)
#define ATT_PV(D0, lo, hv, W0, W1, W2, W3) do { \
                o[D0] = __builtin_amdgcn_mfma_f32_32x32x16_f16(__builtin_bit_cast(h8, W0), ATT_VF(lo, hv, 0), o[D0], 0, 0, 0); \
                o[D0] = __builtin_amdgcn_mfma_f32_32x32x16_f16(__builtin_bit_cast(h8, W1), ATT_VF(lo, hv, 1), o[D0], 0, 0, 0); \
                o[D0] = __builtin_amdgcn_mfma_f32_32x32x16_f16(__builtin_bit_cast(h8, W2), ATT_VF(lo, hv, 2), o[D0], 0, 0, 0); \
                o[D0] = __builtin_amdgcn_mfma_f32_32x32x16_f16(__builtin_bit_cast(h8, W3), ATT_VF(lo, hv, 3), o[D0], 0, 0, 0); } while (0)
            {
                s16x4 l0[4], h0[4], l1[4], h1[4]; u32x4 wa0, wa1, wa2, wa3, wb0, wb1, wb2, wb3;
                ATT_VLOAD(l0, h0, 0);
                __builtin_amdgcn_sched_barrier(0);
                ATT_EXPPACK(p0, p1, wa0, wa1, wa2, wa3);
                ATT_VLOAD(l1, h1, 4096);
                __builtin_amdgcn_sched_barrier(0);
                ATT_PV(0, l0, h0, wa0, wa1, wa2, wa3);
                ATT_EXPPACK(p2, p3, wb0, wb1, wb2, wb3);
                __builtin_amdgcn_s_setprio(0);
                __builtin_amdgcn_sched_barrier(0);
                ATT_VLOAD(l0, h0, TILE_V);
                __builtin_amdgcn_sched_barrier(0);
                ATT_PV(1, l1, h1, wa0, wa1, wa2, wa3);
                __builtin_amdgcn_sched_barrier(0);
                ATT_VLOAD(l1, h1, TILE_V + 4096);
                __builtin_amdgcn_sched_barrier(0);
                ATT_PV(0, l0, h0, wb0, wb1, wb2, wb3);
                __builtin_amdgcn_sched_barrier(0);
                ATT_PV(1, l1, h1, wb0, wb1, wb2, wb3);
            }
#undef ATT_VLOAD
#undef ATT_VF
#undef ATT_EXPPACK
#undef ATT_PV
        }
        ATT_WAITBAR(0);
        slot ^= 1;
    }
    if (threadIdx.x == 0 && (!GATH || u.last)) nxt = __hip_atomic_fetch_add(qctr, 1u, __ATOMIC_RELAXED, __HIP_MEMORY_SCOPE_AGENT);
    { const auto rr = __builtin_amdgcn_permlane32_swap(__float_as_uint(l_reg), __float_as_uint(l_reg), false, false); l_reg = __uint_as_float(rr[0]) + __uint_as_float(rr[1]); }
    if constexpr (GATH) { const unsigned e = ent[qi]; if (hi == 0 && !(e & 0x8000u)) *(f32x2*)(u.paml + ((size_t)((e >> 13) & 3u) * T * 4 + (size_t)(e & 0x1fffu) * 4) * 2) = (f32x2){dlt, l_reg}; }
    else if constexpr (PART) { if (hi == 0) *(f32x2*)(u.ml + (long)qi * u.mls) = (f32x2){dlt, l_reg}; }
    if constexpr (SINK) l_reg += __builtin_amdgcn_exp2f(u.sink2 - dlt);
    if (hi == 0) wsf[32 + r32] = l_reg;
    asm volatile("s_waitcnt lgkmcnt(0)" ::: "memory");
    float rli[16];
#pragma unroll
    for (int r = 0; r < 16; ++r) rli[r] = __builtin_amdgcn_rcpf(wsf[32 + crow(r, hi)]);
    { LAS f16* stg = (LAS f16*)(lds + L_OST) + wid * 2048;
#pragma unroll
      for (int r = 0; r < 16; ++r) { const int orow = crow(r, hi);
#pragma unroll
          for (int d0 = 0; d0 < 2; ++d0) stg[orow * 64 + d0 * 32 + r32] = (f16)(o[d0][r] * rli[r]); }
      asm volatile("s_waitcnt lgkmcnt(0)" ::: "memory");
#pragma unroll
      for (int i = 0; i < 4; ++i) { const int row = i * 8 + (lane >> 3), ch = lane & 7; const u32x4 v = *(const LAS u32x4*)(stg + row * 64 + ch * 8);
          if constexpr (GATH) { const unsigned e = ent[32 * wid + row]; const unsigned sl = (e >> 13) & 3u; f16* pb = (sl == 2u) ? u.pa2 : u.pa01 + (size_t)sl * T * 256;
              if (!(e & 0x8000u)) *(u32x4*)(pb + (size_t)(e & 0x1fffu) * 256 + ch * 8) = v; }
          else *(u32x4*)(u.o + (long)(32 * wid + row) * u.os + ch * 8) = v; } }
    if constexpr (GATH) { if (u.nnext > 0 && tid < 256) ((LAS unsigned*)(lds + L_ENT) + 256 * (u.par ^ 1))[tid] = e_next; }
    asm volatile("s_waitcnt lgkmcnt(0)\n\ts_barrier" ::: "memory");
#undef ATT_DMA
#undef ATT_DMA1
}
}

template <int D> __device__ __forceinline__ float dotq(const float (&q)[D], const f16* kr) {
    float s0 = 0.f, s1 = 0.f;
#pragma unroll
    for (int c = 0; c < D / 8; ++c) { const h8 kv = *(const h8*)(kr + 8 * c);
#pragma unroll
        for (int j = 0; j < 8; j += 2) { s0 += q[8 * c + j] * (float)kv[j]; s1 += q[8 * c + j + 1] * (float)kv[j + 1]; } }
    return s0 + s1;
}
__device__ __forceinline__ void axpy64(float (&o)[64], float p, const f16* vr) {
#pragma unroll
    for (int c = 0; c < 8; ++c) { const h8 vv = *(const h8*)(vr + 8 * c);
#pragma unroll
        for (int j = 0; j < 8; ++j) o[8 * c + j] += p * (float)vv[j]; }
}
template <int D> __device__ __forceinline__ void loadq(float (&q)[D], const f16* qr) {
#pragma unroll
    for (int c = 0; c < D / 8; ++c) { const h8 v = *(const h8*)(qr + 8 * c);
#pragma unroll
        for (int j = 0; j < 8; ++j) q[8 * c + j] = (float)v[j]; }
}
__device__ __forceinline__ void store64(f16* orow, const float (&o)[64], float inv) {
#pragma unroll
    for (int c = 0; c < 8; ++c) { u32x4 w; w.x = pk2h(o[8 * c] * inv, o[8 * c + 1] * inv); w.y = pk2h(o[8 * c + 2] * inv, o[8 * c + 3] * inv); w.z = pk2h(o[8 * c + 4] * inv, o[8 * c + 5] * inv); w.w = pk2h(o[8 * c + 6] * inv, o[8 * c + 7] * inv);
        *(u32x4*)(orow + 8 * c) = w; }
}
#define KEYSTEP(DQ, vld_, bias_, krow_, vrow_) do { const bool vld = (vld_); const float s = dotq<DQ>(q, (krow_)) + (bias_); \
    if (__any(vld && s > m)) { const float mn = vld ? fmaxf(m, s) : m; const float f = __builtin_amdgcn_exp2f(m - mn); l *= f; _Pragma("unroll") for (int d_ = 0; d_ < 64; ++d_) o[d_] *= f; m = mn; } \
    const float p = vld ? __builtin_amdgcn_exp2f(s - m) : 0.f; l += p; axpy64(o, p, (vrow_)); } while (0)

__device__ __forceinline__ float alibi_slope(int idx) { return exp2f((-8.0f * (float)idx) / 12.0f); }

__device__ __forceinline__ void valu_moba(Frame& F, int b, int h, int c) {
    const int lane = lane_id(); const f16* HB = (const f16*)(F.ws + WS_HB); const float* KMP = (const float*)(F.ws + WS_KMP); f16* OR = (f16*)(F.ws + WS_OR);
    const int t = 64 * c + lane; const size_t row = (size_t)b * SEQ + t; const int qblk = c >> 2;
    float q[64]; loadq<64>(q, HB + row * HBP + C_AQ + 64 * h);
    float v1 = -INFINITY, v2 = -INFINITY, v3 = -INFINITY; int i1 = -1, i2 = -1, i3 = -1;
    for (int j = 0; j < qblk; ++j) {
        const float* k0 = KMP + ((size_t)(b * 32 + j) * 4 + h) * 256;
        float g = 0.f;
#pragma unroll
        for (int d = 0; d < 64; ++d) g += q[d] * ((k0[d] + k0[64 + d]) + (k0[128 + d] + k0[192 + d]));
        if (g > v1) { v3 = v2; i3 = i2; v2 = v1; i2 = i1; v1 = g; i1 = j; } else if (g > v2) { v3 = v2; i3 = i2; v2 = g; i2 = j; } else if (g > v3) { v3 = g; i3 = j; }
    }
    unsigned sel = 0u; if (i1 >= 0) sel |= 1u << i1; if (i2 >= 0) sel |= 1u << i2; if (i3 >= 0) sel |= 1u << i3;
    const float sl2 = alibi_slope(1 + 3 * h) * LOG2E;
    float o[64]; float m = -1e30f, l = 0.f;
#pragma unroll
    for (int d = 0; d < 64; ++d) o[d] = 0.f;
    for (int j = 0; j <= qblk; ++j) {
        const bool mine = (j == qblk) || ((sel >> j) & 1u);
        if (!__any(mine)) continue;
        const int kend = (j == qblk) ? min(256, 64 * (c & 3) + 64) : 256;
        for (int kk = 0; kk < kend; ++kk) { const int kpos = 256 * j + kk; const f16* kr = HB + ((size_t)b * SEQ + kpos) * HBP;
            KEYSTEP(64, mine && kpos <= t, sl2 * (float)(kpos - t), kr + C_AK + 64 * h, kr + C_AV + 64 * h); }
    }
    store64(OR + row * DM + 0 + 64 * h, o, 1.0f / l);
}
__device__ __forceinline__ void valu_mla(Frame& F, int b, int h, int c) {
    const int lane = lane_id(); const f16* QB = (const f16*)(F.ws + WS_QB); const f16* KB = (const f16*)(F.ws + WS_KB); const f16* VB = (const f16*)(F.ws + WS_VB); f16* OR = (f16*)(F.ws + WS_OR);
    const int t = 64 * c + lane; const size_t row = (size_t)b * SEQ + t;
    float q[96]; loadq<96>(q, QB + row * 384 + 96 * h);
    float o[64]; float m = -1e30f, l = 0.f;
#pragma unroll
    for (int d = 0; d < 64; ++d) o[d] = 0.f;
    const int kend = 64 * c + 64;
    for (int kpos = 0; kpos < kend; ++kpos) { const size_t rk = (size_t)b * SEQ + kpos;
        KEYSTEP(96, kpos <= t, 0.f, KB + rk * 384 + 96 * h, VB + rk * 256 + 64 * h); }
    store64(OR + row * DM + 256 + 64 * h, o, 1.0f / l);
}
__device__ __forceinline__ void valu_dil(Frame& F, int b, int h, int br, int r, int n, int hf) {
    const int lane = lane_id(); const f16* HB = (const f16*)(F.ws + WS_HB); f16* CPO = (f16*)((unsigned char*)F.out + OUT_CPO); float* CPML = (float*)(F.ws + WS_CPML);
    const int d = (br == 0) ? 1 : (br == 1 ? 4 : 16);
    const int i = 64 * hf + lane; const int t = (128 * n + i) * d + r; const size_t row = (size_t)b * SEQ + t;
    float q[64]; loadq<64>(q, HB + row * HBP + C_CQ + 64 * h);
    const float sl2 = alibi_slope(2 + 3 * h) * LOG2E * (float)d;
    float o[64]; float m = -1e30f, l = 0.f;
#pragma unroll
    for (int dd = 0; dd < 64; ++dd) o[dd] = 0.f;
    for (int kidx = 64 * hf; kidx < 64 * hf + 192; ++kidx) { const int sp = 128 * (n - 1) + kidx; if (sp < 0) continue;
        const int kpos = sp * d + r; const int rel = i + 128 - kidx; const f16* kr = HB + ((size_t)b * SEQ + kpos) * HBP;
        KEYSTEP(64, rel >= 0 && rel <= 128, -sl2 * (float)rel, kr + C_CK + 64 * h, kr + C_CV + 64 * h); }
    store64(CPO + ((size_t)br * T + row) * 256 + 64 * h, o, 1.0f / l);
    *(f32x2*)(CPML + (((size_t)br * T + row) * 4 + h) * 2) = (f32x2){m, l};
}
__device__ __forceinline__ void valu_swa(Frame& F, const Args& args, int l_, int b, int hq, int n, int hf) {
    const int lane = lane_id(); const f16* HB = (const f16*)(F.ws + WS_HB); f16* OR = (f16*)(F.ws + WS_OR);
    const int kvh = hq >> 1; const int i = 64 * hf + lane; const int t = 128 * n + i; const size_t row = (size_t)b * SEQ + t;
    float q[64]; loadq<64>(q, HB + row * HBP + C_DQ + 64 * hq);
    const float sl2 = alibi_slope(3 + 3 * hq) * LOG2E;
    float o[64]; float m = -1e30f, l = 0.f;
#pragma unroll
    for (int dd = 0; dd < 64; ++dd) o[dd] = 0.f;
    for (int kidx = 64 * hf; kidx < 64 * hf + 192; ++kidx) { const int kpos = 128 * (n - 1) + kidx; if (kpos < 0) continue;
        const int rel = i + 128 - kidx; const f16* kr = HB + ((size_t)b * SEQ + kpos) * HBP;
        KEYSTEP(64, rel >= 0 && rel < 128, -sl2 * (float)rel, kr + C_DK + 64 * kvh, kr + C_DV + 64 * kvh); }
    const float sk = args.in[I_SINK][l_ * 4 + hq] * LOG2E; const float M = fmaxf(m, sk);
    const float f = __builtin_amdgcn_exp2f(m - M); const float den = l * f + __builtin_amdgcn_exp2f(sk - M);
    store64(OR + row * DM + 768 + 64 * hq, o, f / den);
}
__device__ __forceinline__ void phase_attn_valu(Frame& F, const Args& args, int l) {
    const int gw = __builtin_amdgcn_readfirstlane(F.vcu * NWAVES + wave_id()), NGW = F.G * NWAVES;
    constexpr int NB = 1024, NA = 1024, NC = 3072, ND = 1024;
    for (int u = gw; u < NB + NA + NC + ND; u += NGW) {
        int r = u;
        if (r < NB) { const int c = 127 - (r >> 3), bh = r & 7; if (ATT_VALU & 2) valu_mla(F, bh >> 2, bh & 3, c); continue; } r -= NB;
        if (r < NA) { const int c = 127 - (r >> 3), bh = r & 7; if (ATT_VALU & 1) valu_moba(F, bh >> 2, bh & 3, c); continue; } r -= NA;
        if (r < NC) { const int hf = r & 1, bh = (r >> 1) & 7, rn = (r >> 4) & 63, br = r >> 10; const int d = (br == 0) ? 1 : (br == 1 ? 4 : 16); const int nbk = 64 / d;
            if (ATT_VALU & 4) valu_dil(F, bh >> 2, bh & 3, br, rn / nbk, rn % nbk, hf); continue; } r -= NC;
        { const int hf = r & 1, bh = (r >> 1) & 7, n = r >> 4; if (ATT_VALU & 8) valu_swa(F, args, l, bh >> 2, bh & 3, n, hf); }
    }
}


__device__ __forceinline__ void phase_attn(Frame& F, const Args& args, int l, int rep) {
    const f16* HB = (const f16*)(F.ws + WS_HB); f16* OR = (f16*)(F.ws + WS_OR);
    unsigned* qctr = (unsigned*)(F.ws + WS_CTL) + 8192 + 64 * (l + 2 * rep);
    volatile LAS unsigned* flag = (volatile LAS unsigned*)(F.lds + att::L_FLAG);
    constexpr int NB = 256, NAP = 248, NAO = 256, NC = 768, ND = 256;
    unsigned nxt = 0u;
    if (threadIdx.x == 0) nxt = __hip_atomic_fetch_add(qctr, 1u, __ATOMIC_RELAXED, __HIP_MEMORY_SCOPE_AGENT);
    for (;;) {
        if (threadIdx.x == 0) flag[0] = nxt;
        __syncthreads();
        const int id = (int)__builtin_amdgcn_readfirstlane((int)flag[0]);
        __syncthreads();
        if (id >= NB + NAP + NAO + NC + ND) break;
#define ATT_TAKE() do { if (threadIdx.x == 0) nxt = __hip_atomic_fetch_add(qctr, 1u, __ATOMIC_RELAXED, __HIP_MEMORY_SCOPE_AGENT); } while (0)
        att::AU u{}; int r = id;
        if (r < NB) {
            if (ATT_VALU & 2) { ATT_TAKE(); continue; }
            const int qb = 31 - (r >> 3), bh = r & 7, b = bh >> 2, h = bh & 3; const size_t row0 = (size_t)b * SEQ + 256 * qb;
            u.q = (const f16*)(F.ws + WS_QB) + row0 * 384 + 96 * h; u.k = (const f16*)(F.ws + WS_KB) + row0 * 384 + 96 * h; u.v = (const f16*)(F.ws + WS_VB) + row0 * 256 + 64 * h;
            u.o = OR + row0 * DM + 256 + 64 * h; u.qs = 384; u.ks = 384; u.vs = 256; u.os = DM; u.t_lo = -4 * qb; u.t_hi = 4; u.qb = qb;
            att::attn_unit<96, 0, false, false, false, 0>(F.lds, u, qctr, nxt); continue; }
        r -= NB;
        if (r < NAP) {
            if (ATT_VALU & 1) { ATT_TAKE(); continue; }
            const int j = r >> 3, bh = r & 7, b = bh >> 2, h = bh & 3;
            const int n = (int)__builtin_amdgcn_readfirstlane((int)__hip_atomic_load((unsigned*)(F.ws + WS_CTL) + CW_LCNT + l * 256 + bh * 32 + j, __ATOMIC_RELAXED, __HIP_MEMORY_SCOPE_AGENT));
            if (n <= 0) { ATT_TAKE(); continue; }
            const size_t rb = (size_t)b * SEQ, rk = rb + 256 * j;
            u.q = HB + rb * HBP + C_AQ + 64 * h; u.k = HB + rk * HBP + C_AK + 64 * h; u.v = HB + rk * HBP + C_AV + 64 * h;
            u.qs = HBP; u.ks = HBP; u.vs = HBP; u.t_lo = 0; u.t_hi = 4; u.jblk = j; u.h = h; u.slope2 = alibi_slope(1 + 3 * h) * LOG2E;
            u.pa01 = (f16*)(F.ws + WS_PA01) + rb * 256 + 64 * h; u.pa2 = (f16*)((unsigned char*)F.out + OUT_PA2) + rb * 256 + 64 * h; u.paml = (float*)(F.ws + WS_PAML) + (rb * 4 + h) * 2;
            const unsigned short* lb = (const unsigned short*)(F.ws + WS_LIST) + (size_t)bh * LIST_STRIDE + 256 * (31 * j - (j * (j - 1)) / 2);
            for (int c0 = 0; c0 < n; c0 += 256) { u.list = lb + c0; u.nrows = (n - c0 < 256) ? (n - c0) : 256; u.last = (c0 + 256 >= n) ? 1 : 0; u.kvres = (c0 > 0) ? 1 : 0; u.par = (c0 >> 8) & 1; { const int rem = n - c0 - 256; u.nnext = rem <= 0 ? 0 : (rem < 256 ? rem : 256); }
                att::attn_unit<64, 2, false, false, false, 0, true>(F.lds, u, qctr, nxt); }
            continue; }
        r -= NAP;
        if (r < NAO) {
            if (ATT_VALU & 1) { ATT_TAKE(); continue; }
            const int qb = 31 - (r >> 3), bh = r & 7, b = bh >> 2, h = bh & 3; const size_t row0 = (size_t)b * SEQ + 256 * qb;
            u.q = HB + row0 * HBP + C_AQ + 64 * h; u.k = HB + row0 * HBP + C_AK + 64 * h; u.v = HB + row0 * HBP + C_AV + 64 * h;
            u.o = OR + row0 * DM + 64 * h; u.qs = HBP; u.ks = HBP; u.vs = HBP; u.os = DM; u.t_lo = 0; u.t_hi = 4; u.qb = qb;
            u.ml = (float*)(F.ws + WS_PAML) + (((size_t)3 * T + row0) * 4 + h) * 2; u.mls = 8;
            u.slope2 = alibi_slope(1 + 3 * h) * LOG2E;
            att::attn_unit<64, 0, false, false, true, 0>(F.lds, u, qctr, nxt); continue; }
        r -= NAO;
        if (r < NC) {
            if (ATT_VALU & 4) { ATT_TAKE(); continue; }
            const int br = r >> 8, rest = r & 255, bh = rest & 7, un = rest >> 3, b = bh >> 2, h = bh & 3; const int d = (br == 0) ? 1 : (br == 1 ? 4 : 16); const int per = 32 / d;
            const int res = un / per, ublk = un % per; const size_t row0 = (size_t)b * SEQ + (size_t)256 * ublk * d + res;
            u.q = HB + row0 * HBP + C_CQ + 64 * h; u.k = HB + row0 * HBP + C_CK + 64 * h; u.v = HB + row0 * HBP + C_CV + 64 * h;
            u.o = (f16*)((unsigned char*)F.out + OUT_CPO) + ((size_t)br * T + row0) * 256 + 64 * h; u.ml = (float*)(F.ws + WS_CPML) + (((size_t)br * T + row0) * 4 + h) * 2;
            u.qs = d * HBP; u.ks = d * HBP; u.vs = d * HBP; u.os = d * 256; u.mls = d * 8; u.t_lo = ublk ? -2 : 0; u.t_hi = 4;
            u.slope2 = alibi_slope(2 + 3 * h) * LOG2E * (float)d;
            att::attn_unit<64, 1, false, false, true, 128>(F.lds, u, qctr, nxt); continue; }
        r -= NC;
        {
            if (ATT_VALU & 8) { ATT_TAKE(); continue; }
            const int bh = r & 7, ublk = r >> 3, b = bh >> 2, hq = bh & 3, kvh = hq >> 1; const size_t row0 = (size_t)b * SEQ + 256 * ublk;
            u.q = HB + row0 * HBP + C_DQ + 64 * hq; u.k = HB + row0 * HBP + C_DK + 64 * kvh; u.v = HB + row0 * HBP + C_DV + 64 * kvh;
            u.o = OR + row0 * DM + 768 + 64 * hq; u.qs = HBP; u.ks = HBP; u.vs = HBP; u.os = DM; u.t_lo = ublk ? -2 : 0; u.t_hi = 4;
            u.slope2 = alibi_slope(3 + 3 * hq) * LOG2E; u.sink2 = args.in[I_SINK][l * 4 + hq] * LOG2E;
            att::attn_unit<64, 1, false, true, false, 127>(F.lds, u, qctr, nxt); }
#undef ATT_TAKE
    }
#if ATT_VALU
    phase_attn_valu(F, args, l);
#endif
    { unsigned* qc2 = qctr + 16;
        const int nsub = (l == 0) ? (cv::DEFER0 + cv::I_IN + cv::I_O + cv::I_UQ + cv::I_UKV) : (cv::I_UP + cv::I_DN); const int nconv = (nsub + NWAVES - 1) / NWAVES;
        LAS float* scr = (LAS float*)(F.lds + wave_id() * 17408);
        volatile LAS unsigned* flag2 = (volatile LAS unsigned*)(F.lds + 146944 + 64);
        for (;;) {
            __syncthreads();
            if (threadIdx.x == 0) flag2[0] = __hip_atomic_fetch_add(qc2, 1u, __ATOMIC_RELAXED, __HIP_MEMORY_SCOPE_AGENT);
            __syncthreads();
            const int id = (int)__builtin_amdgcn_readfirstlane((int)flag2[0]);
            if (id >= nconv) break;
            const int d = id * NWAVES + wave_id();
            if (d < nsub) {
                if (l == 0) { if (d < cv::DEFER0) convert_subitem(F, args, 0, cv::I_IN + d, scr, lane_id());
                              else { const int e = d - cv::DEFER0; convert_subitem(F, args, 1, e < cv::I_IN + cv::I_O ? e : (cv::PER_L - cv::I_UQ - cv::I_UKV) + (e - cv::I_IN - cv::I_O), scr, lane_id()); } }
                else convert_subitem(F, args, 1, cv::I_IN + cv::I_O + d, scr, lane_id());
            }
        } }
}

typedef GAS unsigned gu32;
#define XB_TMO      128
#define XB_XCNT(j)  (256  + 64 * (j))
#define XB_XSUB(j)  (1280 + 64 * (j))
#define XB_XGEN(j)  (2304 + 64 * (j))
#define XB_TOP      3328
#define XB_TOPGEN   3392
#define XCD_BAR_WORDS 3456
#define XB_SPIN_CAP (1u << 22)
__device__ __forceinline__ unsigned xb_ld(unsigned* p)              { return __hip_atomic_load(p, __ATOMIC_RELAXED, __HIP_MEMORY_SCOPE_AGENT); }
__device__ __forceinline__ unsigned xb_add(unsigned* p, unsigned v) { return __hip_atomic_fetch_add(p, v, __ATOMIC_RELAXED, __HIP_MEMORY_SCOPE_AGENT); }
__device__ __forceinline__ unsigned xb_xcc_id() { return (unsigned)__builtin_amdgcn_s_getreg((3 << 11) | 20) & 0xFu; }
#define XB_SPIN(cond, bar) do { unsigned _sp = 0; while (cond) { __builtin_amdgcn_s_sleep(1); \
    if ((++_sp & 255u) == 0u) { if (xb_ld(&(bar)[XB_TMO])) break; if (_sp > XB_SPIN_CAP) { atomicAdd(&(bar)[XB_TMO], 1u); break; } } } } while (0)
struct XcdBarrier { unsigned* bar; unsigned x; volatile LAS unsigned* st; };
__device__ __forceinline__ XcdBarrier xcd_barrier_post(unsigned* bar, volatile LAS unsigned* st) {
    XcdBarrier b; b.bar = bar; b.x = xb_xcc_id(); b.st = st;
    if (threadIdx.x == 0) (void)xb_add(&bar[XB_XCNT(b.x)], 1u);
    return b;
}
__device__ __forceinline__ void xcd_barrier_complete(unsigned* bar, unsigned x, unsigned& nloc, unsigned& nx) {
    const unsigned G = gridDim.x * gridDim.y * gridDim.z;
    unsigned sum, cnt, mine, sp = 0u;
    for (;;) {
        sum = 0u; cnt = 0u; mine = 0u;
#pragma unroll
        for (unsigned j = 0; j < 16; ++j) { const unsigned c = xb_ld(&bar[XB_XCNT(j)]); sum += c; cnt += (c > 0u) ? 1u : 0u; mine = (j == x) ? c : mine; }
        if (sum == G) break;
        __builtin_amdgcn_s_sleep(1);
        if ((++sp & 255u) == 0u) { if (xb_ld(&bar[XB_TMO])) break; if (sp > XB_SPIN_CAP) { atomicAdd(&bar[XB_TMO], 1u); break; } }
    }
    nloc = mine > 0u ? mine : 1u; nx = cnt > 0u ? cnt : 1u;
}
__device__ __forceinline__ void xcd_barrier(const XcdBarrier& b) {
    asm volatile("s_waitcnt vmcnt(0)" ::: "memory");
    __syncthreads();
    if (threadIdx.x == 0) {
        unsigned* bar = b.bar;
        __builtin_amdgcn_s_waitcnt(0);
        unsigned nloc = b.st[0], nx = b.st[1];
        if (nloc == 0u) { xcd_barrier_complete(bar, b.x, nloc, nx); b.st[0] = nloc; b.st[1] = nx; }
        const unsigned old = xb_add(&bar[XB_XSUB(b.x)], 1u);
        const unsigned gen = old / nloc;
        if (old + 1u == (gen + 1u) * nloc) {
            __builtin_amdgcn_fence(__ATOMIC_RELEASE, "agent");
            asm volatile("s_waitcnt vmcnt(0)" ::: "memory");
            const unsigned og = xb_add(&bar[XB_TOP], 1u);
            const unsigned tg = og / nx;
            __builtin_amdgcn_fence(__ATOMIC_ACQUIRE, "agent");
            if (og + 1u == (tg + 1u) * nx) xb_add(&bar[XB_TOPGEN], 1u);
            else XB_SPIN(xb_ld(&bar[XB_TOPGEN]) == tg, bar);
            xb_add(&bar[XB_XGEN(b.x)], 1u);
            asm volatile("s_waitcnt vmcnt(0)" ::: "memory");
        } else {
            __builtin_amdgcn_fence(__ATOMIC_ACQUIRE, "agent");
            XB_SPIN(xb_ld(&bar[XB_XGEN(b.x)]) == gen, bar);
            asm volatile("s_waitcnt vmcnt(0)" ::: "memory");
        }
    }
    __syncthreads();
}

#ifndef PHMASK
#define PHMASK 0xfff
#endif
#ifndef REPMASK
#define REPMASK 0
#endif
#define REP(k) for (int rep_ = 0; rep_ < (((REPMASK >> (k)) & 1) ? 2 : 1); ++rep_)
constexpr int PH_PER_LAYER = 11, N_PHASES = 1 + DEPTH * PH_PER_LAYER;
#define PH_FENCE() asm volatile("" ::: "memory")
#define PH_ENTER(k) do { if (P0 + (k) > lo) xcd_barrier(bar); PH_FENCE(); } while (0)
template <int L> __device__ __forceinline__ void run_layer(Frame& F, const Args& args, int lo, int hi, const XcdBarrier& bar) {
    constexpr int P0 = 1 + L * PH_PER_LAYER;
    const float* rs_in = (L == 0) ? (const float*)(F.ws + WS_RS) : (const float*)(F.ws + WS_XBUF) + (size_t)(2 * L - 1) * T * 4;
#define IN(k) (((PHMASK >> (k)) & 1) && lo <= P0 + (k) && P0 + (k) < hi)
    if (IN(0)) {
        PH_ENTER(0);
        pg8::Gemm g{(const f16*)(F.ws + WS_XN), wt_ptr(F, L, WO_IN), T, 2048, DM, DM}; pg8::StaticOrder S; S.init(T, 2048, F.G, (int)blockIdx.x);
        pg8::EpiIn E{(f16*)(F.ws + WS_HB), (const float*)wt_ptr(F, L, WO_GT), 0, rs_in, (float*)(F.ws + WS_LSS)};
        REP(0) { if (rep_) xcd_barrier(bar); pg8::gemm_phase<pg8::EpiIn, true, true>(F.lds, g, S, E); }
        { pg8::Unit u0; bool any = false; for (int i = 0; S.next(i, u0); ++i) if (u0.pn == 1) any = true;
          if (any) { VM_WAIT(); __syncthreads(); for (int i = 0; S.next(i, u0); ++i) if (u0.pn == 1) kmean_block(F, u0.pm); } } }
    if (IN(2)) {
        PH_ENTER(2);
        const int hg = F.G / 2;
        if ((int)blockIdx.x < hg) {
            pg8::Gemm g{(const f16*)(F.ws + WS_XN), wt_ptr(F, L, WO_IN) + (size_t)2048 * DM, T, 512, DM, DM}; pg8::StaticOrder S; S.init(T, 512, hg, (int)blockIdx.x);
            pg8::EpiIn E{(f16*)(F.ws + WS_HB), (const float*)wt_ptr(F, L, WO_GT), 8, rs_in, nullptr};
            pg8::gemm_phase<pg8::EpiIn, true, true>(F.lds, g, S, E);
            phase_mla_post(F, args, L, (int)blockIdx.x * NWAVES + wave_id(), hg * NWAVES, 0, 0, (int)blockIdx.x);
        } else {
            const int c = (int)blockIdx.x - hg; const float* ct = (const float*)(F.ws + WS_ROPE); const float* st = ct + SEQ * 16;
            { pg8::Gemm g{(const f16*)(F.ws + WS_HB) + C_QL, wt_ptr(F, L, WO_UQ), T, 512, 256, HBP}; pg8::StaticOrder S; S.init(T, 512, hg, c);
              pg8::EpiMlaQ E{(f16*)(F.ws + WS_QB), (const float*)(F.ws + WS_LSS), args.in[I_BQG] + L * 96, ct, st}; pg8::gemm_phase<pg8::EpiMlaQ, false, true>(F.lds, g, S, E); }
            __syncthreads();
            { pg8::Gemm g{(const f16*)(F.ws + WS_HB) + C_KVL, wt_ptr(F, L, WO_UKV), T, 512, 256, HBP}; pg8::StaticOrder S; S.init(T, 512, hg, c);
              pg8::EpiMlaKV E{(f16*)(F.ws + WS_KB), (f16*)(F.ws + WS_VB), (const f16*)(F.ws + WS_HB), (const float*)(F.ws + WS_LSS) + (size_t)T * 4, args.in[I_BKG] + L * 96, ct, st}; pg8::gemm_phase<pg8::EpiMlaKV, false, true>(F.lds, g, S, E); }
        } }
    if (IN(4)) { PH_ENTER(4); REP(4) { if (rep_) xcd_barrier(bar); phase_attn(F, args, L, rep_); } }
    if (IN(5)) { PH_ENTER(5); phase_mix(F, args, L); }
    if (IN(6)) {
        PH_ENTER(6);
        pg8::Gemm g{(const f16*)(F.ws + WS_OR), wt_ptr(F, L, WO_O), T, DM, DM, DM}; pg8::StaticOrder S; S.init(T, DM, F.G, (int)blockIdx.x);
        pg8::EpiResNorm E{(f16*)(F.ws + WS_XN), nullptr, (float*)(F.ws + WS_XBUF) + (size_t)(2 * L) * T * 4, 1};
        pg8::gemm_phase<pg8::EpiResNorm, false, true>(F.lds, g, S, E); }
    if (IN(8)) {
        PH_ENTER(8);
        pg8::Gemm g{(const f16*)(F.ws + WS_XN), wt_ptr(F, L, WO_UP), T, DFF, DM, DM}; pg8::StaticOrder S; S.init(T, DFF, F.G, (int)blockIdx.x);
        pg8::EpiF16<1> E{(f16*)(F.ws + WS_H), DFF, (const float*)(F.ws + WS_XBUF) + (size_t)(2 * L) * T * 4}; REP(8) { if (rep_) xcd_barrier(bar); pg8::gemm_phase<pg8::EpiF16<1>, true, true>(F.lds, g, S, E); } }
    if (IN(9)) {
        PH_ENTER(9);
        pg8::Gemm g{(const f16*)(F.ws + WS_H), wt_ptr(F, L, WO_DOWN), T, DM, DFF, DFF}; pg8::StaticOrder S; S.init(T, DM, F.G, (int)blockIdx.x);
        pg8::EpiResNorm E{(f16*)(F.ws + WS_XN), (L + 1 < DEPTH) ? nullptr : F.out, (float*)(F.ws + WS_XBUF) + (size_t)(2 * L + 1) * T * 4, (L + 1 < DEPTH) ? 1 : 0};
        pg8::gemm_phase<pg8::EpiResNorm, false, true>(F.lds, g, S, E); }
#undef IN
}
__global__ void __launch_bounds__(NWAVES * 64, 2) mega(Args args) {
    extern __shared__ __attribute__((aligned(16))) unsigned char lds_raw[];
    Frame F;
    F.lds = (LAS unsigned char*)lds_raw;
        F.G = gridDim.x; { const int bx = blockIdx.x; F.vcu = (F.G % 8 == 0) ? (bx % 8) * (F.G / 8) + bx / 8 : bx; }
    F.out = args.out; F.ws = args.ws;
    const int lo = args.ph_lo, hi = args.ph_hi;
    volatile LAS unsigned* MISC = (volatile LAS unsigned*)(F.lds + 146944);
    if (threadIdx.x < 32) MISC[threadIdx.x] = 0u;
    __syncthreads();
    XcdBarrier bar; bar.bar = (unsigned*)(F.ws + WS_CTL) + 4096; bar.x = 0; bar.st = nullptr;
    if (hi - lo > 1) bar = xcd_barrier_post((unsigned*)(F.ws + WS_CTL) + 4096, MISC + 8);
    if ((PHMASK & 0x800) && lo <= 0 && 0 < hi) REP(11) { if (rep_) xcd_barrier(bar); phase_prologue(F, args); }
    run_layer<0>(F, args, lo, hi, bar);
    run_layer<1>(F, args, lo, hi, bar);
}

extern "C" void kernel_launch(void* const* d_in, const int* in_sizes, int n_in, void* d_out, int out_size, void* d_ws, size_t ws_size, hipStream_t stream) {
    static int grid = 0;
    if (grid == 0) {
        if (n_in != 21 || out_size != T * DM || ws_size < WS_END) { fprintf(stderr, "kernel_launch: unexpected shapes (n_in %d, out %d, ws %zu)\n", n_in, out_size, ws_size); grid = -1; return; }
        if (hipFuncSetAttribute((const void*)mega, hipFuncAttributeMaxDynamicSharedMemorySize, LDS_BYTES) != hipSuccess) { fprintf(stderr, "kernel_launch: hipFuncSetAttribute failed\n"); grid = -1; return; }
        int dev = 0, cus = 0; hipGetDevice(&dev); hipDeviceGetAttribute(&cus, hipDeviceAttributeMultiprocessorCount, dev);
        int per_cu = 0;
        if (hipOccupancyMaxActiveBlocksPerMultiprocessor(&per_cu, (const void*)mega, NWAVES * 64, LDS_BYTES) != hipSuccess || per_cu < 1) fprintf(stderr, "kernel_launch: occupancy query reports %d blocks per CU\n", per_cu);
        (void)hipGetLastError();
        grid = cus > 0 ? cus : 256;
    }
    if (grid < 0) return;
    Args a{};
    for (int i = 0; i < 21; ++i) a.in[i] = (const float*)d_in[i];
    a.out = (float*)d_out; a.ws = (unsigned char*)d_ws;
#if defined(MK_MULTI)
    for (int ph = 0; ph < N_PHASES - 1; ++ph) {
        a.ph_lo = ph; a.ph_hi = ph + 1; a.li = ph;
        hipLaunchKernelGGL(mega, dim3(grid), dim3(NWAVES * 64), LDS_BYTES, stream, a);
    }
#else
    if (hipMemsetAsync((char*)d_ws + WS_CTL, 0, 131072, stream) != hipSuccess) { fprintf(stderr, "kernel_launch: hipMemsetAsync failed\n"); return; }
    a.ph_lo = 0; a.ph_hi = N_PHASES; a.li = 0;
    hipLaunchKernelGGL(mega, dim3(grid), dim3(NWAVES * 64), LDS_BYTES, stream, a);
#endif
}
```

```cpp
#include <hip/hip_runtime.h>
#include <cstdio>
#include <cstdint>
#include <cmath>

#ifndef ATT_VALU
#define ATT_VALU 0
#endif
#define LAS __attribute__((address_space(3)))
#define GAS __attribute__((address_space(1)))
typedef _Float16 f16;
typedef _Float16 h8 __attribute__((ext_vector_type(8)));
typedef _Float16 h4 __attribute__((ext_vector_type(4)));
typedef _Float16 h2 __attribute__((ext_vector_type(2)));
typedef float f32x4 __attribute__((ext_vector_type(4)));
typedef float f32x2 __attribute__((ext_vector_type(2)));
typedef unsigned u32x4 __attribute__((ext_vector_type(4)));
typedef unsigned u32x2 __attribute__((ext_vector_type(2)));


__device__ __forceinline__ void st16f(void* p, f32x4 v) { *(f32x4*)p = v; }
__device__ __forceinline__ void st8(void* p, u32x2 v) { *(u32x2*)p = v; }

constexpr int BATCH = 2, SEQ = 8192, DM = 1024, T = BATCH * SEQ, DEPTH = 2;
constexpr int NIN = 2464, HBP = 2560, DFF = 4096;
constexpr float EPS = 1e-6f;
constexpr float LOG2E = 1.4426950408889634f;
constexpr float C2_64 = 0.125f * LOG2E;
constexpr float C2_96 = 0.10206207261596577f * LOG2E;
constexpr int C_AQ = 0, C_AK = 256, C_AV = 512, C_QL = 768, C_KVL = 1024, C_KR = 1152, C_CQ = 1280, C_CK = 1536, C_CV = 1792, C_DQ = 2048, C_DK = 2304, C_DV = 2432;

constexpr size_t MiB = 1u << 20;
constexpr size_t WS_CTL = 0;
constexpr size_t WS_W = 1 * MiB, W_LAYER = 24 * MiB;
constexpr size_t WO_IN = 0, WO_O = 5 * MiB, WO_UP = 7 * MiB, WO_DOWN = 15 * MiB, WO_UQ = 23 * MiB, WO_UKV = 23 * MiB + 256 * 1024, WO_GT = 23 * MiB + 512 * 1024;
constexpr size_t WS_ROPE = 49 * MiB;
constexpr size_t WS_XN = 50 * MiB;
constexpr size_t OUT_CPO = 0;
constexpr size_t OUT_PA2 = 24 * MiB;
constexpr size_t WS_RS = 246 * MiB;
constexpr size_t WS_HB = 82 * MiB;
constexpr size_t WS_QB = 162 * MiB, WS_KB = 174 * MiB, WS_VB = 186 * MiB;
constexpr size_t WS_QLN = 194 * MiB, WS_KVN = 202 * MiB;
constexpr size_t WS_KMP = 242 * MiB;
constexpr size_t WS_XBUF = 245 * MiB;
constexpr size_t WS_CPML = 243 * MiB;
constexpr size_t WS_H = 82 * MiB;
constexpr size_t WS_OR = 210 * MiB;
constexpr size_t WS_QU = 210 * MiB, WS_KVU = 226 * MiB;
constexpr size_t WS_PA01 = 194 * MiB;
constexpr size_t WS_LSS = 246 * MiB + 256 * 1024;
constexpr size_t WS_LIST = 247 * MiB;
constexpr size_t WS_PAML = 249 * MiB;
constexpr int LIST_STRIDE = 126976;
constexpr int CW_LCNT = 12288;
constexpr size_t WS_END = 256 * MiB;

namespace pg8 {
constexpr int BM = 256, BK = 64, HALF = 128, HTB = HALF * BK * 2, STAGE_BYTES = 8 * HTB, NXCD = 8, WGM = 8;
__host__ __device__ __forceinline__ int lds_byte(int r, int c) { const int st = (r >> 4) * 2 + (c >> 5), rr = r & 15, cc = c & 31, ob = rr * 64 + cc * 2; return st * 1024 + (ob ^ (((ob >> 9) & 1) << 5)); }
__host__ __device__ __forceinline__ void stage_rc(int b, int& R, int& C) { const int st = b / 1024, sb = b % 1024, swz = sb ^ (((sb >> 9) & 1) << 5); R = (st >> 1) * 16 + swz / 64; C = (st & 1) * 32 + (swz % 64) / 2; }
__host__ __device__ __forceinline__ int perm32(int rho) { const int n = rho >> 4, i = rho & 15; return 8 * (i >> 2) + 4 * n + (i & 3); }
struct Unit { int pm, pn; };
struct Gemm { const f16* A; const f16* Bt; int M, N, K, lda; };
struct StaticOrder {
    int nM, nN, nwg, G, c;
    __device__ __forceinline__ void init(int M, int N, int G_, int c_) { nM = M / BM; nN = N / BM; nwg = nM * nN; G = G_; c = c_; }
    __device__ __forceinline__ bool next(int i, Unit& u) const {
        const long L = (long)i * G + c; if (L >= nwg) return false;
        int wgid = (int)L; { const int q = nwg / NXCD, r = nwg % NXCD, xcd = wgid % NXCD, off = wgid / NXCD; wgid = (xcd < r ? xcd * (q + 1) : r * (q + 1) + (xcd - r) * q) + off; }
        const int nig = WGM * nN, gid = wgid / nig, fm = gid * WGM, gsz = (nM - fm) < WGM ? (nM - fm) : WGM;
        u.pm = fm + ((wgid % nig) % gsz); u.pn = (wgid % nig) / gsz; return true;
    }
};
__device__ __forceinline__ u32x4 pack8(f32x4 a, f32x4 b) {
    u32x4 w;
    w.x = __builtin_bit_cast(unsigned, __builtin_convertvector((f32x2){a[0], a[1]}, h2));
    w.y = __builtin_bit_cast(unsigned, __builtin_convertvector((f32x2){a[2], a[3]}, h2));
    w.z = __builtin_bit_cast(unsigned, __builtin_convertvector((f32x2){b[0], b[1]}, h2));
    w.w = __builtin_bit_cast(unsigned, __builtin_convertvector((f32x2){b[2], b[3]}, h2));
    return w;
}
__device__ __forceinline__ float row16_sum(float a) {
    a += __builtin_bit_cast(float, __builtin_amdgcn_update_dpp(0, __builtin_bit_cast(int, a), 0x128, 0xf, 0xf, false));
    a += __builtin_bit_cast(float, __builtin_amdgcn_update_dpp(0, __builtin_bit_cast(int, a), 0x124, 0xf, 0xf, false));
    a += __builtin_bit_cast(float, __builtin_amdgcn_update_dpp(0, __builtin_bit_cast(int, a), 0x122, 0xf, 0xf, false));
    a += __builtin_bit_cast(float, __builtin_amdgcn_update_dpp(0, __builtin_bit_cast(int, a), 0x121, 0xf, 0xf, false));
    return a;
}
__device__ __forceinline__ float rstd_row(const float* xb, int row) { const f32x4 p = *(const f32x4*)(xb + (size_t)row * 4); return __builtin_amdgcn_rsqf(((p[0] + p[1]) + (p[2] + p[3])) * (1.0f / 1024.0f) + EPS); }
template <int ACT> struct EpiF16 {
    static constexpr bool PERM = true, AFTER_DRAIN = false;
    f16* O; int ldc; const float* RS;
    __device__ __forceinline__ void operator()(const f32x4 (&acc)[2][2][4][2], const Unit& u, int wr, int wc) const {
        int lane_ = threadIdx.x & 63; asm volatile("" : "+v"(lane_)); const int fr = lane_ & 15, fq = lane_ >> 4;
        const int row0 = u.pm * BM + wr * 64 + fr, col0 = u.pn * BM + wc * 32 + 8 * fq;
#pragma unroll
        for (int ai = 0; ai < 2; ++ai)
#pragma unroll
            for (int m = 0; m < 4; ++m) { f16* rowp = O + (size_t)(row0 + ai * HALF + m * 16) * ldc + col0; const float rsr = RS ? rstd_row(RS, row0 + ai * HALF + m * 16) : 1.0f;
#pragma unroll
                for (int bj = 0; bj < 2; ++bj) { f32x4 v0 = acc[ai][bj][m][0] * rsr, v1 = acc[ai][bj][m][1] * rsr;
                    if (ACT == 1) {
#pragma unroll
                        for (int e = 0; e < 4; ++e) { const float a = fmaxf(v0[e], 0.f), b = fmaxf(v1[e], 0.f); v0[e] = a * a; v1[e] = b * b; } }
                    *(u32x4*)(rowp + bj * HALF) = pack8(v0, v1); } }
    }
};
struct EpiRes {
    static constexpr bool PERM = false, AFTER_DRAIN = false;
    const float* base; float* out; int ldc;
    __device__ __forceinline__ void operator()(const f32x4 (&acc)[2][2][4][2], const Unit& u, int wr, int wc) const {
        int lane_ = threadIdx.x & 63; asm volatile("" : "+v"(lane_)); const int fr = lane_ & 15, fq = lane_ >> 4;
        const int row0 = u.pm * BM + wr * 64 + fr, col0 = u.pn * BM + wc * 32 + 4 * fq;
#pragma unroll
        for (int ai = 0; ai < 2; ++ai)
#pragma unroll
            for (int m = 0; m < 4; ++m) { const size_t off = (size_t)(row0 + ai * HALF + m * 16) * ldc + col0;
#pragma unroll
                for (int bj = 0; bj < 2; ++bj)
#pragma unroll
                    for (int n = 0; n < 2; ++n) { const f32x4 b = *(const f32x4*)(base + off + bj * HALF + n * 16); *(f32x4*)(out + off + bj * HALF + n * 16) = b + acc[ai][bj][m][n]; } }
    }
};

struct EpiResNorm {
    static constexpr bool PERM = true, AFTER_DRAIN = true, INIT_ACC = true;
    f16* X16; float* outf; float* xbuf; int do_norm;
    __device__ __forceinline__ void init(f32x4 (&acc)[2][2][4][2], const Unit& u, int wr, int wc) const {
        int tid_ = threadIdx.x; asm volatile("" : "+v"(tid_)); const int lane = tid_ & 63, fr = lane & 15, fq = lane >> 4;
        const int row0 = u.pm * BM + wr * 64 + fr, col0 = u.pn * BM + wc * 32 + 8 * fq;
        h8 rb[2][4][2];
#pragma unroll
        for (int ai = 0; ai < 2; ++ai)
#pragma unroll
            for (int m = 0; m < 4; ++m) { const size_t off = (size_t)(row0 + ai * HALF + m * 16) * 1024 + col0;
#pragma unroll
                for (int bj = 0; bj < 2; ++bj) rb[ai][m][bj] = *(const h8*)(X16 + off + bj * HALF); }
#pragma unroll
        for (int ai = 0; ai < 2; ++ai)
#pragma unroll
            for (int m = 0; m < 4; ++m)
#pragma unroll
                for (int bj = 0; bj < 2; ++bj) { const h8 b = rb[ai][m][bj];
                    acc[ai][bj][m][0] = (f32x4){(float)b[0], (float)b[1], (float)b[2], (float)b[3]}; acc[ai][bj][m][1] = (f32x4){(float)b[4], (float)b[5], (float)b[6], (float)b[7]}; }
    }
    __device__ __forceinline__ void fused(f32x4 (&acc)[2][2][4][2], const Unit& u, int wr, int wc, LAS unsigned char* lds) const {
        int tid_ = threadIdx.x; asm volatile("" : "+v"(tid_)); const int lane = tid_ & 63, wid = __builtin_amdgcn_readfirstlane(tid_ >> 6), fr = lane & 15, fq = lane >> 4;
        const int row0 = u.pm * BM + wr * 64 + fr, col0 = u.pn * BM + wc * 32 + 8 * fq;
#pragma unroll
        for (int ai = 0; ai < 2; ++ai)
#pragma unroll
            for (int m = 0; m < 4; ++m) { const size_t off = (size_t)(row0 + ai * HALF + m * 16) * 1024 + col0;
#pragma unroll
                for (int bj = 0; bj < 2; ++bj) {
                    const f32x4 v0 = acc[ai][bj][m][0], v1 = acc[ai][bj][m][1];
                    if (outf) { st16f(outf + off + bj * HALF, v0); st16f(outf + off + bj * HALF + 4, v1); }
                    else *(u32x4*)(X16 + off + bj * HALF) = pack8(v0, v1); } }
        if (!do_norm) return;
        LAS float* P = (LAS float*)lds;
#pragma unroll
        for (int ai = 0; ai < 2; ++ai)
#pragma unroll
            for (int m = 0; m < 4; ++m) { float s = 0.f;
#pragma unroll
                for (int bj = 0; bj < 2; ++bj)
#pragma unroll
                    for (int n = 0; n < 2; ++n) { const f32x4 x = acc[ai][bj][m][n]; s += (x[0] * x[0] + x[1] * x[1]) + (x[2] * x[2] + x[3] * x[3]); }
                s += __shfl_xor(s, 16); s += __shfl_xor(s, 32);
                if (fq == 0) P[(ai * HALF + wr * 64 + m * 16 + fr) * 4 + wc] = s; }
        asm volatile("s_waitcnt lgkmcnt(0)" ::: "memory"); __builtin_amdgcn_s_barrier(); asm volatile("" ::: "memory");
        const int row = wid * 32 + (lane & 31);
        if (lane < 32) { const f32x4 p = *(const LAS f32x4*)(P + row * 4); xbuf[(size_t)(u.pm * BM + row) * 4 + u.pn] = (p[0] + p[1]) + (p[2] + p[3]); }
    }
};
struct EpiIn {
    static constexpr bool PERM = true, AFTER_DRAIN = false;
    f16* HB; const float* GT; int pn0; const float* RS; float* LSS;
    __device__ __forceinline__ void operator()(const f32x4 (&acc)[2][2][4][2], const Unit& u, int wr, int wc) const {
        int lane_ = threadIdx.x & 63; asm volatile("" : "+v"(lane_)); const int fr = lane_ & 15, fq = lane_ >> 4;
        const int pn = u.pn + pn0;
        const bool normed = (pn == 0) | (pn == 1) | (pn == 5) | (pn == 6) | (pn == 8) | ((pn == 9) & (wc < 2));
        const float* g = normed ? GT + (pn * 4 + wc) * 64 : nullptr;
        const int row0 = u.pm * BM + wr * 64 + fr, col0 = pn * BM + wc * 64 + 8 * fq;
        asm volatile("" : "+s"(g));
        if (g) {
            float rs[2][4];
#pragma unroll
            for (int ai = 0; ai < 2; ++ai)
#pragma unroll
                for (int m = 0; m < 4; ++m) {
                    float ss = 0.f;
#pragma unroll
                    for (int bj = 0; bj < 2; ++bj)
#pragma unroll
                        for (int n = 0; n < 2; ++n) { const f32x4 x = acc[ai][bj][m][n]; ss += (x[0] * x[0] + x[1] * x[1]) + (x[2] * x[2] + x[3] * x[3]); }
                    ss += __shfl_xor(ss, 16); ss += __shfl_xor(ss, 32);
                    const float rr = rstd_row(RS, row0 + ai * HALF + m * 16); ss *= rr * rr;
                    rs[ai][m] = rr * __builtin_amdgcn_rsqf(ss * (1.0f / 64.0f) + EPS);
                }
#pragma unroll
            for (int bj = 0; bj < 2; ++bj) {
                const f32x4 g0 = *(const f32x4*)(g + 32 * bj + 8 * fq), g1 = *(const f32x4*)(g + 32 * bj + 8 * fq + 4);
#pragma unroll
                for (int ai = 0; ai < 2; ++ai)
#pragma unroll
                    for (int m = 0; m < 4; ++m) { const f32x4 v0 = acc[ai][bj][m][0] * rs[ai][m] * g0, v1 = acc[ai][bj][m][1] * rs[ai][m] * g1;
                        *(u32x4*)(HB + (size_t)(row0 + ai * HALF + m * 16) * HBP + col0 + bj * 32) = pack8(v0, v1);
                        if (m & 1) asm volatile("" ::: "memory"); }
            }
        } else {
#pragma unroll
            for (int ai = 0; ai < 2; ++ai)
#pragma unroll
                for (int m = 0; m < 4; ++m) { f16* rowp = HB + (size_t)(row0 + ai * HALF + m * 16) * HBP + col0; const float rr = rstd_row(RS, row0 + ai * HALF + m * 16);
#pragma unroll
                    for (int bj = 0; bj < 2; ++bj) *(u32x4*)(rowp + bj * 32) = pack8(acc[ai][bj][m][0] * rr, acc[ai][bj][m][1] * rr); }
            if (LSS && ((pn == 3) | ((pn == 4) & (wc < 2)))) {
#pragma unroll
                for (int ai = 0; ai < 2; ++ai)
#pragma unroll
                    for (int m = 0; m < 4; ++m) { const int row = row0 + ai * HALF + m * 16; const float rr = rstd_row(RS, row); float ss = 0.f;
#pragma unroll
                        for (int bj = 0; bj < 2; ++bj)
#pragma unroll
                            for (int n = 0; n < 2; ++n) { const f32x4 x = acc[ai][bj][m][n]; ss += (x[0] * x[0] + x[1] * x[1]) + (x[2] * x[2] + x[3] * x[3]); }
                        ss += __shfl_xor(ss, 16); ss += __shfl_xor(ss, 32);
                        if (fq == 0) LSS[((size_t)(pn - 3) * T + row) * 4 + wc] = ss * rr * rr; } }
        }
    }
};

struct EpiMlaQ {
    static constexpr bool PERM = true, AFTER_DRAIN = true;
    f16* QB; const float* LSS; const float* gq; const float* ct; const float* st;
    __device__ __forceinline__ void fused(f32x4 (&acc)[2][2][4][2], const Unit& u, int wr, int wc, LAS unsigned char* lds) const {
        int tid_ = threadIdx.x; asm volatile("" : "+v"(tid_)); const int lane = tid_ & 63, fr = lane & 15, fq = lane >> 4;
        const int row0 = u.pm * BM + wr * 64 + fr, head = 2 * u.pn + (wc >> 1); const bool rope = (wc & 1) != 0;
        LAS float* P = (LAS float*)lds;
        f32x4 lp[2][4];
#pragma unroll
        for (int ai = 0; ai < 2; ++ai)
#pragma unroll
            for (int m = 0; m < 4; ++m) lp[ai][m] = *(const f32x4*)(LSS + (size_t)(row0 + ai * HALF + m * 16) * 4);
        f32x4 g0[2], g1[2];
        if (!rope) {
#pragma unroll
            for (int bj = 0; bj < 2; ++bj) { g0[bj] = *(const f32x4*)(gq + 32 * bj + 8 * fq) * C2_96; g1[bj] = *(const f32x4*)(gq + 32 * bj + 8 * fq + 4) * C2_96; } }
        else { g0[0] = *(const f32x4*)(gq + 64 + 8 * fq) * C2_96; g1[0] = *(const f32x4*)(gq + 64 + 8 * fq + 4) * C2_96; g0[1] = g0[0]; g1[1] = g1[0]; }
        f32x4 cs[2][4];
#define MLA_CS(dst, I) do { const int pos_ = (row0 + ((I) >> 2) * HALF + ((I) & 3) * 16) % SEQ; const float* cp_ = ct + pos_ * 16 + 8 * (fq & 1); const float* sp_ = st + pos_ * 16 + 8 * (fq & 1); \
            dst[0] = *(const f32x4*)cp_; dst[1] = *(const f32x4*)(cp_ + 4); dst[2] = *(const f32x4*)sp_; dst[3] = *(const f32x4*)(sp_ + 4); } while (0)
        if (rope) MLA_CS(cs[0], 0);
        float rl[2][4];
#pragma unroll
        for (int ai = 0; ai < 2; ++ai)
#pragma unroll
            for (int m = 0; m < 4; ++m) { const f32x4 p = lp[ai][m];
                rl[ai][m] = __builtin_amdgcn_rsqf(((p[0] + p[1]) + (p[2] + p[3])) * (1.0f / 256.0f) + EPS); float ss = 0.f;
#pragma unroll
                for (int bj = 0; bj < 2; ++bj)
#pragma unroll
                    for (int n = 0; n < 2; ++n) { const f32x4 x = acc[ai][bj][m][n]; ss += (x[0] * x[0] + x[1] * x[1]) + (x[2] * x[2] + x[3] * x[3]); }
                ss += __shfl_xor(ss, 16); ss += __shfl_xor(ss, 32);
                if (fq == 0) P[(ai * HALF + wr * 64 + m * 16 + fr) * 4 + wc] = ss * rl[ai][m] * rl[ai][m]; }
        asm volatile("s_waitcnt lgkmcnt(0)" ::: "memory"); __builtin_amdgcn_s_barrier(); asm volatile("" ::: "memory");
#pragma unroll
        for (int i = 0; i < 8; ++i) { const int ai = i >> 2, m = i & 3; const int row = row0 + ai * HALF + m * 16; const LAS float* pr = P + (ai * HALF + wr * 64 + m * 16 + fr) * 4 + (wc & 2);
            if (rope && i < 7) MLA_CS(cs[(i + 1) & 1], i + 1);
            const float rs = rl[ai][m] * __builtin_amdgcn_rsqf((pr[0] + pr[1]) * (1.0f / 96.0f) + EPS);
            f16* qo = QB + (size_t)row * 384 + 96 * head;
            if (!rope) {
#pragma unroll
                for (int bj = 0; bj < 2; ++bj) *(u32x4*)(qo + 32 * bj + 8 * fq) = pack8(acc[ai][bj][m][0] * rs * g0[bj], acc[ai][bj][m][1] * rs * g1[bj]);
            } else {
                const f32x4 c0 = cs[i & 1][0], c1 = cs[i & 1][1], s0 = cs[i & 1][2], s1 = cs[i & 1][3];
                const f32x4 b0 = acc[ai][0][m][0] * rs * g0[0], b1 = acc[ai][0][m][1] * rs * g1[0]; f32x4 r0, r1;
#pragma unroll
                for (int e = 0; e < 4; ++e) { const float o0 = __shfl_xor(b0[e], 32), o1 = __shfl_xor(b1[e], 32);
                    r0[e] = (fq < 2) ? (b0[e] * c0[e] - o0 * s0[e]) : (o0 * s0[e] + b0[e] * c0[e]);
                    r1[e] = (fq < 2) ? (b1[e] * c1[e] - o1 * s1[e]) : (o1 * s1[e] + b1[e] * c1[e]); }
                *(u32x4*)(qo + 64 + 8 * fq) = pack8(r0, r1);
            } }
    }
};
struct EpiMlaKV {
    static constexpr bool PERM = true, AFTER_DRAIN = true;
    f16* KB; f16* VB; const f16* HB; const float* LSS; const float* gk; const float* ct; const float* st;
    __device__ __forceinline__ void fused(f32x4 (&acc)[2][2][4][2], const Unit& u, int wr, int wc, LAS unsigned char* lds) const {
        int tid_ = threadIdx.x; asm volatile("" : "+v"(tid_)); const int lane = tid_ & 63, fr = lane & 15, fq = lane >> 4;
        const int row0 = u.pm * BM + wr * 64 + fr, head = 2 * u.pn + (wc >> 1); const bool isv = (wc & 1) != 0;
        f32x2 lp[2][4];
#pragma unroll
        for (int ai = 0; ai < 2; ++ai)
#pragma unroll
            for (int m = 0; m < 4; ++m) lp[ai][m] = *(const f32x2*)(LSS + (size_t)(row0 + ai * HALF + m * 16) * 4);
        f32x4 g0[2], g1[2], gr0, gr1;
        if (!isv) {
#pragma unroll
            for (int bj = 0; bj < 2; ++bj) { g0[bj] = *(const f32x4*)(gk + 32 * bj + 8 * fq); g1[bj] = *(const f32x4*)(gk + 32 * bj + 8 * fq + 4); }
            gr0 = *(const f32x4*)(gk + 64 + 8 * fq); gr1 = *(const f32x4*)(gk + 64 + 8 * fq + 4); }
        f32x4 cs[2][4]; h8 krv[2];
#define MLA_KR(I) (*(const h8*)(HB + (size_t)(row0 + ((I) >> 2) * HALF + ((I) & 3) * 16) * HBP + C_KR + 8 * fq))
        if (!isv) { MLA_CS(cs[0], 0); krv[0] = MLA_KR(0); }
#pragma unroll
        for (int i = 0; i < 8; ++i) { const int ai = i >> 2, m = i & 3; const int row = row0 + ai * HALF + m * 16; const f32x2 p = lp[ai][m];
            const float rk = __builtin_amdgcn_rsqf((p[0] + p[1]) * (1.0f / 128.0f) + EPS);
            if (isv) {
                f16* vo = VB + (size_t)row * 256 + 64 * head;
#pragma unroll
                for (int bj = 0; bj < 2; ++bj) *(u32x4*)(vo + 32 * bj + 8 * fq) = pack8(acc[ai][bj][m][0] * rk, acc[ai][bj][m][1] * rk);
            } else {
                if (i < 7) { MLA_CS(cs[(i + 1) & 1], i + 1); krv[(i + 1) & 1] = MLA_KR(i + 1); }
                const h8 krh = krv[i & 1]; f32x4 k0, k1;
#pragma unroll
                for (int e = 0; e < 4; ++e) { k0[e] = (float)krh[e]; k1[e] = (float)krh[4 + e]; }
                float ss = 0.f, sk = 0.f;
#pragma unroll
                for (int bj = 0; bj < 2; ++bj)
#pragma unroll
                    for (int n = 0; n < 2; ++n) { const f32x4 x = acc[ai][bj][m][n]; ss += (x[0] * x[0] + x[1] * x[1]) + (x[2] * x[2] + x[3] * x[3]); }
#pragma unroll
                for (int e = 0; e < 4; ++e) sk += k0[e] * k0[e] + k1[e] * k1[e];
                ss = ss * rk * rk + sk; ss += __shfl_xor(ss, 16); ss += __shfl_xor(ss, 32);
                const float rs = __builtin_amdgcn_rsqf(ss * (1.0f / 96.0f) + EPS);
                f16* ko = KB + (size_t)row * 384 + 96 * head;
#pragma unroll
                for (int bj = 0; bj < 2; ++bj) *(u32x4*)(ko + 32 * bj + 8 * fq) = pack8(acc[ai][bj][m][0] * (rk * rs) * g0[bj], acc[ai][bj][m][1] * (rk * rs) * g1[bj]);
                const f32x4 c0 = cs[i & 1][0], c1 = cs[i & 1][1], s0 = cs[i & 1][2], s1 = cs[i & 1][3];
                const f32x4 b0 = k0 * rs * gr0, b1 = k1 * rs * gr1; f32x4 r0, r1;
#pragma unroll
                for (int e = 0; e < 4; ++e) { const float o0 = __shfl_xor(b0[e], 32), o1 = __shfl_xor(b1[e], 32);
                    r0[e] = (fq < 2) ? (b0[e] * c0[e] - o0 * s0[e]) : (o0 * s0[e] + b0[e] * c0[e]);
                    r1[e] = (fq < 2) ? (b1[e] * c1[e] - o1 * s1[e]) : (o1 * s1[e] + b1[e] * c1[e]); }
                *(u32x4*)(ko + 64 + 8 * fq) = pack8(r0, r1);
            } }
#undef MLA_KR
#undef MLA_CS
    }
};
template <class E_, class = void> struct epi_init_acc { static constexpr bool value = false; };
template <class E_> struct epi_init_acc<E_, decltype((void)E_::INIT_ACC)> { static constexpr bool value = E_::INIT_ACC; };
template <class Epi, bool ALIGN_EPI, bool SP2>
__device__ __forceinline__ void gemm_phase(LAS unsigned char* lds, const Gemm g, const StaticOrder& S, const Epi& E) {
    int tid_ = threadIdx.x; asm volatile("" : "+v"(tid_));
    const int tid = tid_, wid = __builtin_amdgcn_readfirstlane(tid >> 6), lane = tid & 63, wr = wid >> 2, wc = wid & 3, fr = lane & 15, fq = lane >> 4;
    const int K = g.K, nt = K / BK, lda = g.lda;
    unsigned voffA[2], voffB[2];
#pragma unroll
    for (int i = 0; i < 2; ++i) { int R, C; stage_rc(tid * 16 + i * 8192, R, C); const int Rb = Epi::PERM ? ((R & ~31) + perm32(R & 31)) : R;
        voffA[i] = (unsigned)(R * lda + C) * 2u; voffB[i] = (unsigned)(Rb * K + C) * 2u; }
    const size_t kstep = (size_t)(BK * 2);
    const size_t hstepA = (size_t)HALF * lda * 2, hstepB = (size_t)HALF * K * 2;
    const size_t tstepA = 2 * hstepA, tstepB = 2 * hstepB;
    const unsigned ldsw = (unsigned)wid * 1024u;
    const int aoff = lds_byte(wr * 64 + fr, fq * 8), boff = lds_byte(wc * 32 + fr, fq * 8);
#define PG8_SA(b, h) (((b) * 2 + (h)) * HTB)
#define PG8_SB(b, h) ((4 + (b) * 2 + (h)) * HTB)
#define PG8_STAGE(bufoff, gbase, voff) do { _Pragma("unroll") for (int _i = 0; _i < 2; ++_i) \
        __builtin_amdgcn_global_load_lds((const unsigned*)((const char*)(gbase) + (voff)[_i]), (LAS unsigned*)(lds + (bufoff) + ldsw + _i * 8192), 16, 0, 0); } while (0)
#define PG8_LDA(dst, b, h) do { _Pragma("unroll") for (int m = 0; m < 4; ++m) _Pragma("unroll") for (int k = 0; k < 2; ++k) dst[m][k] = *(const LAS h8*)(lds + PG8_SA(b, h) + aoff + m * 2048 + k * 1024); } while (0)
#define PG8_LDB(dst, b, h) do { _Pragma("unroll") for (int n = 0; n < 2; ++n) _Pragma("unroll") for (int k = 0; k < 2; ++k) dst[n][k] = *(const LAS h8*)(lds + PG8_SB(b, h) + boff + n * 2048 + k * 1024); } while (0)
#define PG8_MMA(ai, bj, At, Bt) do { __builtin_amdgcn_s_setprio(1); _Pragma("unroll") for (int m = 0; m < 4; ++m) _Pragma("unroll") for (int n = 0; n < 2; ++n) _Pragma("unroll") for (int k = 0; k < 2; ++k) \
        acc[ai][bj][m][n] = __builtin_amdgcn_mfma_f32_16x16x32_f16(Bt[n][k], At[m][k], acc[ai][bj][m][n], 0, 0, 0); __builtin_amdgcn_s_setprio(0); } while (0)
#define PG8_WAIT_V(n) asm volatile("s_waitcnt vmcnt(" #n ")" ::: "memory")
#define PG8_WAIT_L(n) asm volatile("s_waitcnt lgkmcnt(" #n ")" ::: "memory")
#define PG8_BAR __builtin_amdgcn_s_barrier()
#define PG8_SCHED __builtin_amdgcn_sched_barrier(0)
    Unit cur, nxt; int ui = 0;
    if (!S.next(0, cur)) return;
    f32x4 acc[2][2][4][2];
    if constexpr (!epi_init_acc<Epi>::value) {
#pragma unroll
    for (int a = 0; a < 2; ++a)
#pragma unroll
        for (int b = 0; b < 2; ++b)
#pragma unroll
            for (int m = 0; m < 4; ++m)
#pragma unroll
                for (int n = 0; n < 2; ++n) acc[a][b][m][n] = (f32x4){0.f, 0.f, 0.f, 0.f};
    }
    h8 At[4][2], B0[2][2], B1[2][2];
    const char* cA = (const char*)g.A + (size_t)cur.pm * tstepA; const char* cB = (const char*)g.Bt + (size_t)cur.pn * tstepB;
    if constexpr (SP2) {
        PG8_STAGE(PG8_SB(0, 0), cB, voffB); PG8_STAGE(PG8_SB(0, 1), cB + hstepB, voffB); PG8_STAGE(PG8_SA(0, 0), cA, voffA); PG8_STAGE(PG8_SA(0, 1), cA + hstepA, voffA);
        if constexpr (epi_init_acc<Epi>::value) { E.init(acc, cur, wr, wc); PG8_WAIT_V(0); if (wr == 1) PG8_BAR; PG8_BAR; }
        else { if (wr == 1) PG8_BAR; PG8_WAIT_V(2); PG8_BAR; }
        PG8_STAGE(PG8_SB(1, 0), cB + kstep, voffB); PG8_STAGE(PG8_SA(1, 0), cA + kstep, voffA); PG8_STAGE(PG8_SB(1, 1), cB + hstepB + kstep, voffB);
        PG8_WAIT_V(6); PG8_BAR;
    } else {
        PG8_STAGE(PG8_SB(0, 0), cB, voffB); PG8_STAGE(PG8_SA(0, 0), cA, voffA); PG8_STAGE(PG8_SB(0, 1), cB + hstepB, voffB); PG8_STAGE(PG8_SA(0, 1), cA + hstepA, voffA);
        if (wr == 1) PG8_BAR;
        PG8_WAIT_V(4); PG8_BAR;
        PG8_STAGE(PG8_SB(1, 0), cB + kstep, voffB); PG8_STAGE(PG8_SA(1, 0), cA + kstep, voffA); PG8_STAGE(PG8_SB(1, 1), cB + hstepB + kstep, voffB);
        PG8_WAIT_V(6); PG8_BAR;
    }
    for (;;) {
        const bool has_next = S.next(ui + 1, nxt);
        const char* nA = has_next ? (const char*)g.A + (size_t)nxt.pm * tstepA : cA; const char* nB = has_next ? (const char*)g.Bt + (size_t)nxt.pn * tstepB : cB;
#pragma nounroll
        for (int t = 0; t < nt; t += 2) {
            const bool last = (t == nt - 2);
            const char* a1 = cA + (size_t)(t + 1) * kstep;
            const char* a2 = last ? nA : cA + (size_t)(t + 2) * kstep; const char* b2 = last ? nB : cB + (size_t)(t + 2) * kstep;
            const char* a3 = a2 + kstep; const char* b3 = b2 + kstep;
            if constexpr (SP2) {
            PG8_LDB(B0, 0, 0); PG8_LDB(B1, 0, 1); PG8_SCHED; PG8_LDA(At, 0, 0); PG8_STAGE(PG8_SA(1, 1), a1 + hstepA, voffA);
            PG8_WAIT_V(8); PG8_WAIT_L(0); PG8_BAR; PG8_MMA(0, 0, At, B0); PG8_MMA(0, 1, At, B1); PG8_BAR; PG8_SCHED;
            PG8_LDA(At, 0, 1); PG8_STAGE(PG8_SB(0, 0), b2, voffB); PG8_STAGE(PG8_SB(0, 1), b2 + hstepB, voffB); PG8_STAGE(PG8_SA(0, 0), a2, voffA);
            PG8_WAIT_V(8); PG8_WAIT_L(0); PG8_BAR; PG8_MMA(1, 0, At, B0); PG8_MMA(1, 1, At, B1); PG8_BAR; PG8_SCHED;
            PG8_LDB(B0, 1, 0); PG8_LDB(B1, 1, 1); PG8_SCHED; PG8_LDA(At, 1, 0); PG8_STAGE(PG8_SA(0, 1), a2 + hstepA, voffA);
            PG8_WAIT_V(8); PG8_WAIT_L(0); PG8_BAR; PG8_MMA(0, 0, At, B0); PG8_MMA(0, 1, At, B1); PG8_BAR; PG8_SCHED;
            PG8_LDA(At, 1, 1); PG8_STAGE(PG8_SB(1, 0), b3, voffB); PG8_STAGE(PG8_SB(1, 1), b3 + hstepB, voffB); PG8_STAGE(PG8_SA(1, 0), a3, voffA);
            PG8_WAIT_V(8); PG8_WAIT_L(0); PG8_BAR; PG8_MMA(1, 0, At, B0); PG8_MMA(1, 1, At, B1); PG8_BAR; PG8_SCHED;
            } else {
            PG8_LDB(B0, 0, 0); PG8_SCHED; PG8_LDA(At, 0, 0); PG8_STAGE(PG8_SA(1, 1), a1 + hstepA, voffA);
            PG8_WAIT_L(8); PG8_BAR; PG8_WAIT_L(0); PG8_MMA(0, 0, At, B0); PG8_BAR; PG8_SCHED;
            PG8_LDB(B1, 0, 1); PG8_STAGE(PG8_SB(0, 0), b2, voffB);
            PG8_BAR; PG8_WAIT_L(0); PG8_MMA(0, 1, At, B1); PG8_BAR;
            PG8_LDA(At, 0, 1); PG8_STAGE(PG8_SA(0, 0), a2, voffA);
            PG8_BAR; PG8_WAIT_L(0); PG8_MMA(1, 0, At, B0); PG8_BAR; PG8_SCHED;
            PG8_STAGE(PG8_SB(0, 1), b2 + hstepB, voffB);
            PG8_WAIT_V(6); PG8_BAR; PG8_MMA(1, 1, At, B1); PG8_BAR;
            PG8_LDB(B0, 1, 0); PG8_SCHED; PG8_LDA(At, 1, 0); PG8_STAGE(PG8_SA(0, 1), a2 + hstepA, voffA);
            PG8_WAIT_L(8); PG8_BAR; PG8_WAIT_L(0); PG8_MMA(0, 0, At, B0); PG8_BAR; PG8_SCHED;
            PG8_LDB(B1, 1, 1); PG8_STAGE(PG8_SB(1, 0), b3, voffB);
            PG8_BAR; PG8_WAIT_L(0); PG8_MMA(0, 1, At, B1); PG8_BAR;
            PG8_LDA(At, 1, 1); PG8_STAGE(PG8_SA(1, 0), a3, voffA);
            PG8_BAR; PG8_WAIT_L(0); PG8_MMA(1, 0, At, B0); PG8_BAR; PG8_SCHED;
            PG8_STAGE(PG8_SB(1, 1), b3 + hstepB, voffB);
            PG8_WAIT_V(6); PG8_BAR; PG8_MMA(1, 1, At, B1); PG8_BAR;
            }
        }
        if constexpr (ALIGN_EPI) { if (wr == 0) PG8_BAR; }
        if constexpr (!Epi::AFTER_DRAIN) E(acc, cur, wr, wc);
        if (!has_next) break;
#pragma unroll
        for (int a = 0; a < 2; ++a)
#pragma unroll
            for (int b = 0; b < 2; ++b)
#pragma unroll
                for (int m = 0; m < 4; ++m)
#pragma unroll
                    for (int n = 0; n < 2; ++n) acc[a][b][m][n] = (f32x4){0.f, 0.f, 0.f, 0.f};
        cur = nxt; cA = nA; cB = nB; ++ui;
        if constexpr (ALIGN_EPI) { if (wr == 1) PG8_BAR; }
    }
    PG8_WAIT_V(0);
    if constexpr (!ALIGN_EPI) { if (wr == 0) PG8_BAR; }
    PG8_BAR;
    if constexpr (Epi::AFTER_DRAIN) E.fused(acc, cur, wr, wc, lds);
#undef PG8_SA
#undef PG8_SB
#undef PG8_STAGE
#undef PG8_LDA
#undef PG8_LDB
#undef PG8_MMA
#undef PG8_WAIT_V
#undef PG8_WAIT_L
#undef PG8_BAR
#undef PG8_SCHED
}
}

constexpr int NWAVES = 8;
constexpr int LDS_BYTES = 147456;
#define LDS_WAIT() asm volatile("s_waitcnt lgkmcnt(0)" ::: "memory")
#define VM_WAIT() asm volatile("s_waitcnt vmcnt(0)" ::: "memory")

struct Args { const float* in[21]; float* out; unsigned char* ws; int ph_lo, ph_hi, li, pad; };
enum { I_X = 0, I_ANG, I_WIN, I_MQG, I_MKG, I_QLG, I_KVLG, I_WUQ, I_WUKV, I_BQG, I_BKG, I_CQG, I_CKG, I_DQG, I_DKG, I_SINK, I_GOG, I_WO, I_MNG, I_WUP, I_WDOWN };

struct Frame {
    LAS unsigned char* lds;
    int vcu, G;
    int cu, xlocal;
    float* out; unsigned char* ws;
};
__device__ __forceinline__ int lane_id() { return threadIdx.x & 63; }
__device__ __forceinline__ int wave_id() { return __builtin_amdgcn_readfirstlane(threadIdx.x >> 6); }
__device__ __forceinline__ float wave_sum(float v) {
#pragma unroll
    for (int o = 1; o < 64; o <<= 1) v += __shfl_xor(v, o);
    return v;
}
__device__ __forceinline__ unsigned pk2h(float lo, float hi) { return __builtin_bit_cast(unsigned, __builtin_convertvector((f32x2){lo, hi}, h2)); }
__device__ __forceinline__ f16* wt_ptr(const Frame& F, int l, size_t off) { return (f16*)(F.ws + WS_W + (size_t)l * W_LAYER + off); }

__device__ __forceinline__ void sincos_d(double a, double& c, double& s) {
    const double k = __builtin_rint(a * 0.63661977236758134308);
    const double r = (a - k * 1.57079632679489655800) - k * 6.12323399573676603587e-17;
    const double r2 = r * r;
    const double sp = r * (1.0 + r2 * (-1.0 / 6 + r2 * (1.0 / 120 + r2 * (-1.0 / 5040 + r2 * (1.0 / 362880 + r2 * (-1.0 / 39916800 + r2 * (1.0 / 6227020800.0)))))));
    const double cp = 1.0 + r2 * (-0.5 + r2 * (1.0 / 24 + r2 * (-1.0 / 720 + r2 * (1.0 / 40320 + r2 * (-1.0 / 3628800 + r2 * (1.0 / 479001600.0))))));
    const int q = (int)((long long)k & 3);
    s = (q == 0) ? sp : (q == 1) ? cp : (q == 2) ? -sp : -cp;
    c = (q == 0) ? cp : (q == 1) ? -sp : (q == 2) ? -cp : sp;
}
__device__ __forceinline__ void tr_item(const float* W, int N, int n0, int k0, f16* WT, int ldk, int drow0, LAS float* scr, int lane, const float* gk = nullptr) {
#pragma unroll
    for (int i = 0; i < 32; ++i) { const int kk = 2 * i + (lane >> 5); float v = (n0 >= 0) ? W[(size_t)(k0 + kk) * N + n0 + (lane & 31)] : 0.f; if (gk) v *= gk[k0 + kk]; scr[kk * 33 + (lane & 31)] = v; }
    LDS_WAIT(); asm volatile("" ::: "memory");
    const int c = lane & 7;
#pragma unroll
    for (int j = 0; j < 4; ++j) { const int n = (lane >> 3) + 8 * j; const LAS float* s = scr + (8 * c) * 33 + n;
        u32x4 o; o.x = pk2h(s[0 * 33], s[1 * 33]); o.y = pk2h(s[2 * 33], s[3 * 33]); o.z = pk2h(s[4 * 33], s[5 * 33]); o.w = pk2h(s[6 * 33], s[7 * 33]);
        *(u32x4*)(WT + (size_t)(drow0 + n) * ldk + k0 + 8 * c) = o; }
    LDS_WAIT(); asm volatile("" ::: "memory");
}
struct TrA { const float* W; int N, srcA, srcB, k0; f16* WT; int ldk, drowA, drowB; const float* gk; };
__device__ __forceinline__ void tr_load(const TrA& a, f32x4 (&v)[16], int lane) {
    const int r4 = lane >> 4, c4 = lane & 15; const int src = (c4 >> 3) ? a.srcB : a.srcA;
#pragma unroll
    for (int i = 0; i < 16; ++i) { const int k = 4 * i + r4; v[i] = (f32x4){0.f, 0.f, 0.f, 0.f};
        if (src >= 0) v[i] = *(const f32x4*)(a.W + (size_t)(a.k0 + k) * a.N + src + 4 * (c4 & 7)); }
    if (a.gk) {
#pragma unroll
        for (int i = 0; i < 16; ++i) v[i] = v[i] * a.gk[a.k0 + 4 * i + r4]; }
}
__device__ __forceinline__ void tr_finish(const TrA& a, const f32x4 (&v)[16], LAS float* scr, int lane) {
    const int r4 = lane >> 4, c4 = lane & 15;
#pragma unroll
    for (int i = 0; i < 16; ++i) { const int k = 4 * i + r4; *(LAS f32x4*)(scr + k * 68 + ((4 * c4 + 4 * (k >> 3)) & 63)) = v[i]; }
    LDS_WAIT(); asm volatile("" ::: "memory");
    const int c = lane & 7;
#pragma unroll
    for (int j = 0; j < 8; ++j) { const int n = (lane >> 3) + 8 * j; const LAS float* sp = scr + (8 * c) * 68 + ((n + 4 * c) & 63);
        u32x4 o; o.x = pk2h(sp[0 * 68], sp[1 * 68]); o.y = pk2h(sp[2 * 68], sp[3 * 68]); o.z = pk2h(sp[4 * 68], sp[5 * 68]); o.w = pk2h(sp[6 * 68], sp[7 * 68]);
        const int row = (n < 32) ? (a.drowA + n) : (a.drowB + n - 32);
        *(u32x4*)(a.WT + (size_t)row * a.ldk + a.k0 + 8 * c) = o; }
    LDS_WAIT(); asm volatile("" ::: "memory");
}
namespace cv { constexpr int I_IN = 16 * 40, I_O = 16 * 16, I_UP = 16 * 64, I_DN = 64 * 16, I_UQ = 4 * 8, I_UKV = 2 * 8; constexpr int PER_L = I_IN + I_O + I_UP + I_DN + I_UQ + I_UKV;
    constexpr int URGENT0 = I_IN, DEFER0 = I_O + I_UP + I_DN, NDEFER = DEFER0 + PER_L; }
__device__ __forceinline__ TrA tr_args(Frame& F, const Args& args, int l, int r) {
    using namespace cv;
    if (r < I_IN) { const int kb = r / 40, g = r % 40, pn = g >> 2, wc = g & 3; const int c0 = 256 * pn + 64 * wc, c1 = c0 + 32;
        const int ocA = c0 < 1184 ? c0 : (c0 < 1280 ? -1 : c0 - 96), ocB = c1 < 1184 ? c1 : (c1 < 1280 ? -1 : c1 - 96);
        return TrA{args.in[I_WIN] + (size_t)l * DM * NIN, NIN, ocA, ocB, 64 * kb, wt_ptr(F, l, WO_IN), DM, 256 * pn + 32 * wc, 256 * pn + 128 + 32 * wc, args.in[I_ANG] + l * DM}; } r -= I_IN;
    if (r < I_O) { const int kb = r / 16, nb = r % 16; return TrA{args.in[I_WO] + (size_t)l * DM * DM, DM, 64 * nb, 64 * nb + 32, 64 * kb, wt_ptr(F, l, WO_O), DM, 64 * nb, 64 * nb + 32, nullptr}; } r -= I_O;
    if (r < I_UP) { const int kb = r / 64, nb = r % 64; return TrA{args.in[I_WUP] + (size_t)l * DM * DFF, DFF, 64 * nb, 64 * nb + 32, 64 * kb, wt_ptr(F, l, WO_UP), DM, 64 * nb, 64 * nb + 32, args.in[I_MNG] + l * DM}; } r -= I_UP;
    if (r < I_DN) { const int kb = r / 16, nb = r % 16; return TrA{args.in[I_WDOWN] + (size_t)l * DFF * DM, DM, 64 * nb, 64 * nb + 32, 64 * kb, wt_ptr(F, l, WO_DOWN), DFF, 64 * nb, 64 * nb + 32, nullptr}; } r -= I_DN;
    if (r < I_UQ) { const int kb = r / 8, g = r % 8, pn = g >> 2, wc = g & 3, hd = 2 * pn + (wc >> 1); const bool rope = (wc & 1) != 0;
        return TrA{args.in[I_WUQ] + (size_t)l * 256 * 384, 384, rope ? 96 * hd + 64 : 96 * hd, rope ? -1 : 96 * hd + 32, 64 * kb, wt_ptr(F, l, WO_UQ), 256, 256 * pn + 32 * wc, 256 * pn + 128 + 32 * wc, args.in[I_QLG] + l * 256}; } r -= I_UQ;
    { const int kb = r / 8, g = r % 8, pn = g >> 2, wc = g & 3, hd = 2 * pn + (wc >> 1); const int c0 = 128 * hd + ((wc & 1) ? 64 : 0);
        return TrA{args.in[I_WUKV] + (size_t)l * 128 * 512, 512, c0, c0 + 32, 64 * kb, wt_ptr(F, l, WO_UKV), 128, 256 * pn + 32 * wc, 256 * pn + 128 + 32 * wc, args.in[I_KVLG] + l * 128}; }
}
__device__ __forceinline__ void convert_subitem(Frame& F, const Args& args, int l, int r, LAS float* scr, int lane) {
    const TrA a = tr_args(F, args, l, r); f32x4 v[16]; tr_load(a, v, lane); tr_finish(a, v, scr, lane);
}
__device__ __forceinline__ void phase_prologue(Frame& F, const Args& args) {
    LAS float* scr = (LAS float*)(F.lds + wave_id() * 17408);
    const int gw = F.vcu * NWAVES + wave_id(), NGW = F.G * NWAVES;
    for (int it = gw; it < cv::URGENT0 + cv::I_UQ + cv::I_UKV; it += NGW) convert_subitem(F, args, 0, it < cv::URGENT0 ? it : (cv::PER_L - cv::I_UQ - cv::I_UKV) + (it - cv::URGENT0), scr, lane_id());
    { const int gt = (F.vcu * NWAVES + wave_id()) * 64 + lane_id(), NGT = NGW * 64; const u32x4 z = {0u, 0u, 0u, 0u};
      for (int i = gt; i < DEPTH * 2560; i += NGT) { const int l = i / 2560, pn = (i % 2560) / 256, d = i % 64, hh = (i % 256) / 64; float v = 0.f; float* gt_ = (float*)wt_ptr(F, l, WO_GT) - l * 2560;
          if (pn == 0) v = args.in[I_MQG][l * 64 + d] * C2_64; else if (pn == 1) v = args.in[I_MKG][l * 64 + d]; else if (pn == 5) v = args.in[I_CQG][l * 64 + d] * C2_64;
          else if (pn == 6) v = args.in[I_CKG][l * 64 + d]; else if (pn == 8) v = args.in[I_DQG][l * 64 + d] * C2_64; else if (pn == 9 && hh < 2) v = args.in[I_DKG][l * 64 + d];
          gt_[i] = v; }
      float* ct = (float*)(F.ws + WS_ROPE); float* st = ct + SEQ * 16;
      for (int i = gt; i < SEQ * 16; i += NGT) { const int pos = i / 16, j = i % 16; double invd = 1.0; for (int q = 0; q < j; ++q) invd *= 0.56234132519034908;
          const float ang = (float)pos * (float)invd; double cs, sn; sincos_d((double)ang, cs, sn); ct[i] = (float)cs; st[i] = (float)sn; }
    }
    { f16* X16 = (f16*)(F.ws + WS_XN); float* RS = (float*)(F.ws + WS_RS);
      const int lane = lane_id(); f32x4 v[4], w[4]; int m = gw;
      if (m < T) {
#pragma unroll
          for (int jj = 0; jj < 4; ++jj) v[jj] = ((const f32x4*)(args.in[I_X] + (size_t)m * DM))[lane + 64 * jj]; }
      while (m < T) { const int nx = m + NGW;
#pragma unroll
          for (int jj = 0; jj < 4; ++jj) w[jj] = v[jj];
          if (nx < T) {
#pragma unroll
              for (int jj = 0; jj < 4; ++jj) v[jj] = ((const f32x4*)(args.in[I_X] + (size_t)nx * DM))[lane + 64 * jj]; }
          float ssum = 0.f;
#pragma unroll
          for (int jj = 0; jj < 4; ++jj) ssum += (w[jj].x * w[jj].x + w[jj].y * w[jj].y) + (w[jj].z * w[jj].z + w[jj].w * w[jj].w);
          const float tot = wave_sum(ssum);
          if (lane == 0) *(f32x4*)(RS + (size_t)m * 4) = (f32x4){tot, 0.f, 0.f, 0.f};
          u32x2* o8 = (u32x2*)(X16 + (size_t)m * DM) + lane;
#pragma unroll
          for (int jj = 0; jj < 4; ++jj) { u32x2 ww; ww.x = pk2h(w[jj].x, w[jj].y); ww.y = pk2h(w[jj].z, w[jj].w); o8[64 * jj] = ww; }
          m = nx; } }
}

__device__ __forceinline__ float half_sum(float v) { v += __shfl_xor(v, 1); v += __shfl_xor(v, 2); v += __shfl_xor(v, 4); v += __shfl_xor(v, 8); v += __shfl_xor(v, 16); return v; }
__device__ __forceinline__ void phase_mla_post(Frame& F, const Args& args, int l, int gw_, int NGW_, int tok0, int ntok, int sel_cu) {
    const int gw = F.vcu * NWAVES + wave_id(), NGW = F.G * NWAVES, lane = lane_id(), hf = lane >> 5, j = lane & 31;
    const f16* HB = (const f16*)(F.ws + WS_HB); const f16* QU = (const f16*)(F.ws + WS_QU); const f16* KVU = (const f16*)(F.ws + WS_KVU);
    f16* QB = (f16*)(F.ws + WS_QB); f16* KB = (f16*)(F.ws + WS_KB); f16* VB = (f16*)(F.ws + WS_VB);
    const float* gq = args.in[I_BQG] + l * 96; const float* gk = args.in[I_BKG] + l * 96;
    const float* ct = (const float*)(F.ws + WS_ROPE); const float* st = ct + SEQ * 16;
    const float gq0 = gq[2 * j], gq1 = gq[2 * j + 1], gq2 = gq[64 + j], gk0 = gk[2 * j], gk1 = gk[2 * j + 1], gk2 = gk[64 + j];
    struct PostIn { h8 ql; h4 kl; float kr; h2 qn[4]; float qrp[4]; h2 kn[4], vn[4]; float c, sn; };
#define POST_LOAD(P, m2_) do { const int m_ = 2 * (m2_) + hf; const f16* hr_ = HB + (size_t)m_ * HBP; \
        P.ql = *(const h8*)(hr_ + C_QL + 8 * j); P.kl = *(const h4*)(hr_ + C_KVL + 4 * j); P.kr = (float)hr_[C_KR + j]; \
        const f16* qu_ = QU + (size_t)m_ * 512; const f16* kvu_ = KVU + (size_t)m_ * 512; \
        _Pragma("unroll") for (int h = 0; h < 4; ++h) { P.qn[h] = *(const h2*)(qu_ + 96 * h + 2 * j); P.qrp[h] = (float)qu_[96 * h + 64 + j]; P.kn[h] = *(const h2*)(kvu_ + 128 * h + 2 * j); P.vn[h] = *(const h2*)(kvu_ + 128 * h + 64 + 2 * j); } \
        const int pos_ = m_ % SEQ; P.c = ct[pos_ * 16 + (j & 15)]; P.sn = st[pos_ * 16 + (j & 15)]; } while (0)
    const int tokend = tok0 + ntok;
    PostIn cur; int m2 = tok0 + gw_;
    if (m2 < tokend) POST_LOAD(cur, m2);
    while (m2 < tokend) {
        const int nx = m2 + NGW_; PostIn nxt = cur;
        if (nx < tokend) POST_LOAD(nxt, nx);
        const int m = 2 * m2 + hf;
        const float kr = cur.kr, c = cur.c, sn = cur.sn;
        float sq = 0.f, sk = 0.f;
#pragma unroll
        for (int e = 0; e < 8; ++e) sq += (float)cur.ql[e] * (float)cur.ql[e];
#pragma unroll
        for (int e = 0; e < 4; ++e) sk += (float)cur.kl[e] * (float)cur.kl[e];
        const float rq = __builtin_amdgcn_rsqf(half_sum(sq) * (1.0f / 256.0f) + EPS), rk = __builtin_amdgcn_rsqf(half_sum(sk) * (1.0f / 128.0f) + EPS);
        f16* qo = QB + (size_t)m * 384; f16* ko = KB + (size_t)m * 384; f16* vo = VB + (size_t)m * 256;
#pragma unroll
        for (int h = 0; h < 4; ++h) {
            { const float a0 = (float)cur.qn[h][0] * rq, a1 = (float)cur.qn[h][1] * rq, b = cur.qrp[h] * rq;
              const float rs = __builtin_amdgcn_rsqf(half_sum(a0 * a0 + a1 * a1 + b * b) * (1.0f / 96.0f) + EPS);
              const float bn = b * rs * gq2; const float other = __shfl_xor(bn, 16);
              const float r = ((j & 16) == 0) ? (bn * c - other * sn) : (other * sn + bn * c);
              *(unsigned*)(qo + 96 * h + 2 * j) = pk2h(a0 * rs * gq0 * C2_96, a1 * rs * gq1 * C2_96); qo[96 * h + 64 + j] = (f16)(r * C2_96); }
            { const float k0 = (float)cur.kn[h][0] * rk, k1 = (float)cur.kn[h][1] * rk;
              const float rs = __builtin_amdgcn_rsqf(half_sum(k0 * k0 + k1 * k1 + kr * kr) * (1.0f / 96.0f) + EPS);
              const float bn = kr * rs * gk2; const float other = __shfl_xor(bn, 16);
              const float r = ((j & 16) == 0) ? (bn * c - other * sn) : (other * sn + bn * c);
              *(unsigned*)(ko + 96 * h + 2 * j) = pk2h(k0 * rs * gk0, k1 * rs * gk1); ko[96 * h + 64 + j] = (f16)r;
              *(unsigned*)(vo + 64 * h + 2 * j) = pk2h((float)cur.vn[h][0] * rk, (float)cur.vn[h][1] * rk); }
        }
        cur = nxt; m2 = nx;
    }
#undef POST_LOAD
    {
        const float* KM = (const float*)(F.ws + WS_KMP); unsigned* lcnt = (unsigned*)(F.ws + WS_CTL) + CW_LCNT + l * 256;
        unsigned short* lists = (unsigned short*)(F.ws + WS_LIST); float* paml = (float*)(F.ws + WS_PAML);
        LAS float* kms = (LAS float*)F.lds;
        if (sel_cu >= 0) for (int wi = sel_cu; wi < 8 * 16; wi += 128) { const int bh = wi & 7, cg = wi >> 3, b = bh >> 2, h = bh & 3; const int c = (wave_id() < 4) ? 4 * cg + wave_id() : 127 - (4 * cg + wave_id() - 4);     const int t = 64 * c + lane, qblk = c >> 2; const size_t row = (size_t)b * SEQ + t;
            __syncthreads();
            for (int i = threadIdx.x; i < 32 * 64; i += 512) { const float* kq = KM + ((size_t)(b * 32 + (i >> 6)) * 4 + h) * 256 + (i & 63); kms[i] = (kq[0] + kq[64]) + (kq[128] + kq[192]); }
            __syncthreads();
            float q[64];
            { const f16* qrow = HB + row * HBP + C_AQ + 64 * h;
#pragma unroll
              for (int cc = 0; cc < 8; ++cc) { const h8 v = *(const h8*)(qrow + 8 * cc);
#pragma unroll
                  for (int jj = 0; jj < 8; ++jj) q[8 * cc + jj] = (float)v[jj]; } }
            float v1 = -INFINITY, v2 = -INFINITY, v3 = -INFINITY; int i1 = -1, i2 = -1, i3 = -1;
            for (int jb = 0; jb < qblk; ++jb) { const LAS float* km = kms + 64 * jb;
                float g0 = 0.f, g1 = 0.f;
#pragma unroll
                for (int cc = 0; cc < 16; ++cc) { const f32x4 kv = *(const LAS f32x4*)(km + 4 * cc); g0 += q[4 * cc] * kv[0] + q[4 * cc + 2] * kv[2]; g1 += q[4 * cc + 1] * kv[1] + q[4 * cc + 3] * kv[3]; }
                const float g = g0 + g1;
                if (g > v1) { v3 = v2; i3 = i2; v2 = v1; i2 = i1; v1 = g; i1 = jb; } else if (g > v2) { v3 = v2; i3 = i2; v2 = g; i2 = jb; } else if (g > v3) { v3 = g; i3 = jb; } }
            unsigned selbits = 0u; if (i1 >= 0) selbits |= 1u << i1; if (i2 >= 0) selbits |= 1u << i2; if (i3 >= 0) selbits |= 1u << i3;
            const unsigned long long ltmask = (1ull << lane) - 1ull;
            unsigned mycount = 0u, rk1 = 0u, rk2 = 0u, rk3 = 0u;
            for (int jb = 0; jb < qblk; ++jb) { const unsigned long long bj = __ballot((selbits >> jb) & 1u);
                const unsigned rnk = (unsigned)__popcll(bj & ltmask);
                if (jb == i1) rk1 = rnk; if (jb == i2) rk2 = rnk; if (jb == i3) rk3 = rnk;
                if (lane == jb) mycount = (unsigned)__popcll(bj); }
            unsigned base = 0u;
            if (mycount) base = __hip_atomic_fetch_add(lcnt + bh * 32 + lane, mycount, __ATOMIC_RELAXED, __HIP_MEMORY_SCOPE_AGENT);
#pragma unroll
            for (int sl = 0; sl < 3; ++sl) { const int jb = (sl == 0) ? i1 : (sl == 1 ? i2 : i3); const unsigned rnk = (sl == 0) ? rk1 : (sl == 1 ? rk2 : rk3);
                const unsigned bs = (unsigned)__shfl((int)base, jb >= 0 ? jb : 0);
                if (jb >= 0) lists[(size_t)bh * LIST_STRIDE + 256 * (31 * jb - (jb * (jb - 1)) / 2) + bs + rnk] = (unsigned short)(t | (sl << 13));
                else *(f32x2*)(paml + (((size_t)sl * T + row) * 4 + h) * 2) = (f32x2){0.f, 0.f}; } }
    }
}
__device__ __forceinline__ void kmean_block(Frame& F, int bb) {
    const int lane = lane_id();
    const f16* HB = (const f16*)(F.ws + WS_HB); float* KM = (float*)(F.ws + WS_KMP);
#pragma unroll 1
    for (int i2 = 0; i2 < 2; ++i2) { const int it = bb * 16 + wave_id() * 2 + i2; const int h = (it >> 2) & 3, qr = it & 3;
        const f16* kp = HB + ((size_t)bb * 256 + qr * 64 + (lane >> 3)) * HBP + C_AK + 64 * h + 8 * (lane & 7);
        h8 v[8];
#pragma unroll
        for (int i = 0; i < 8; ++i) v[i] = *(const h8*)(kp + (size_t)(8 * i) * HBP);
        float acc8[8];
#pragma unroll
        for (int e = 0; e < 8; ++e) { float a = 0.f;
#pragma unroll
            for (int i = 0; i < 8; ++i) a += (float)v[i][e];
            a += __shfl_xor(a, 8); a += __shfl_xor(a, 16); a += __shfl_xor(a, 32); acc8[e] = a * (1.0f / 256.0f); }
        if (lane < 8) { float* o = KM + (size_t)it * 64 + 8 * lane; *(f32x4*)o = (f32x4){acc8[0], acc8[1], acc8[2], acc8[3]}; *(f32x4*)(o + 4) = (f32x4){acc8[4], acc8[5], acc8[6], acc8[7]}; } }
}
__device__ __forceinline__ void phase_kmean(Frame& F, int gw, int NGW) {
    const int lane = lane_id();
    const f16* HB = (const f16*)(F.ws + WS_HB); float* KM = (float*)(F.ws + WS_KMP);
    for (int it = gw; it < BATCH * 32 * 4 * 4; it += NGW) { const int bb = it >> 4, h = (it >> 2) & 3, qr = it & 3;
        const f16* kp = HB + ((size_t)bb * 256 + qr * 64 + (lane >> 3)) * HBP + C_AK + 64 * h + 8 * (lane & 7);
        h8 v[8];
#pragma unroll
        for (int i = 0; i < 8; ++i) v[i] = *(const h8*)(kp + (size_t)(8 * i) * HBP);
        float acc8[8];
#pragma unroll
        for (int e = 0; e < 8; ++e) { float a = 0.f;
#pragma unroll
            for (int i = 0; i < 8; ++i) a += (float)v[i][e];
            a += __shfl_xor(a, 8); a += __shfl_xor(a, 16); a += __shfl_xor(a, 32); acc8[e] = a * (1.0f / 256.0f); }
        if (lane < 8) { float* o = KM + (size_t)it * 64 + 8 * lane; *(f32x4*)o = (f32x4){acc8[0], acc8[1], acc8[2], acc8[3]}; *(f32x4*)(o + 4) = (f32x4){acc8[4], acc8[5], acc8[6], acc8[7]}; } }
}
__device__ __forceinline__ void phase_mix(Frame& F, const Args& args, int l) {
    const int gw = F.vcu * NWAVES + wave_id(), NGW = F.G * NWAVES, lane = lane_id();
    f16* OR = (f16*)(F.ws + WS_OR); const f16* CPO = (const f16*)((const unsigned char*)F.out + OUT_CPO); const float* CPML = (const float*)(F.ws + WS_CPML);
    const f16* PA01 = (const f16*)(F.ws + WS_PA01); const f16* PA2 = (const f16*)((const unsigned char*)F.out + OUT_PA2); const float* PAML = (const float*)(F.ws + WS_PAML);
    const float* gog = args.in[I_GOG] + l * 1024;
    const int grp = lane >> 4, cl = (lane & 15) * 16, h = cl >> 6;
    const bool isA = (grp == 0) && !(ATT_VALU & 1), isC = (grp == 2), plain = !isA && !isC;
    const f16* own = OR + lane * 16;
    const f16* sb[4]; int sst[4]; const float* mb_[4]; bool used[4];
#pragma unroll
    for (int p = 0; p < 4; ++p) { sb[p] = own; sst[p] = DM; mb_[p] = PAML; used[p] = false; }
    if (isA) { sb[0] = PA01 + cl; sb[1] = PA01 + (size_t)T * 256 + cl; sb[2] = PA2 + cl; sst[0] = sst[1] = sst[2] = 256;
#pragma unroll
        for (int p = 0; p < 4; ++p) { mb_[p] = PAML + ((size_t)p * T * 4 + h) * 2; used[p] = true; } }
    if (isC) {
#pragma unroll
        for (int p = 0; p < 3; ++p) { sb[p] = CPO + (size_t)p * T * 256 + cl; sst[p] = 256; mb_[p] = CPML + ((size_t)p * T * 4 + h) * 2; used[p] = true; } }
    float gg[16];
#pragma unroll
    for (int e = 0; e < 16; ++e) gg[e] = gog[lane * 16 + e];
    struct MixIn { h8 x[4][2]; f32x2 ml[4]; };
#define MIX_LOAD(I, m_) do { _Pragma("unroll") for (int p = 0; p < 4; ++p) { const f16* sp_ = sb[p] + (size_t)(m_) * sst[p]; I.x[p][0] = *(const h8*)sp_; I.x[p][1] = *(const h8*)(sp_ + 8); I.ml[p] = *(const f32x2*)(mb_[p] + (size_t)(m_) * 8); } } while (0)
    MixIn cur; int m = gw;
    if (m < T) MIX_LOAD(cur, m);
    while (m < T) {
        const int nx = m + NGW; MixIn nxt = cur;
        if (nx < T) MIX_LOAD(nxt, nx);
        float M = plain ? 0.f : -INFINITY;
#pragma unroll
        for (int p = 0; p < 4; ++p) if (used[p]) M = fmaxf(M, cur.ml[p].x);
        float w[4], den = 0.f;
#pragma unroll
        for (int p = 0; p < 4; ++p) { const float lp = used[p] ? cur.ml[p].y : ((plain && p == 0) ? 1.0f : 0.f); const float dp = used[p] ? cur.ml[p].x : M;
            w[p] = (lp > 0.f) ? exp2f(dp - M) * lp : 0.f; den += w[p]; }
        float v[16];
#pragma unroll
        for (int e = 0; e < 16; ++e) v[e] = 0.f;
#pragma unroll
        for (int p = 0; p < 4; ++p) { const bool ok = w[p] > 0.f;
#pragma unroll
            for (int e = 0; e < 8; ++e) { v[e] += ok ? w[p] * (float)cur.x[p][0][e] : 0.f; v[8 + e] += ok ? w[p] * (float)cur.x[p][1][e] : 0.f; } }
        const float inv = 1.0f / den;
        float ss = 0.f;
#pragma unroll
        for (int e = 0; e < 16; ++e) { v[e] *= inv; ss += v[e] * v[e]; }
        ss += __shfl_xor(ss, 1); ss += __shfl_xor(ss, 2); ss += __shfl_xor(ss, 4); ss += __shfl_xor(ss, 8);
        const float rs = __builtin_amdgcn_rsqf(ss * (1.0f / 256.0f) + EPS);
        u32x4 w0, w1;
        w0.x = pk2h(v[0] * rs * gg[0], v[1] * rs * gg[1]); w0.y = pk2h(v[2] * rs * gg[2], v[3] * rs * gg[3]); w0.z = pk2h(v[4] * rs * gg[4], v[5] * rs * gg[5]); w0.w = pk2h(v[6] * rs * gg[6], v[7] * rs * gg[7]);
        w1.x = pk2h(v[8] * rs * gg[8], v[9] * rs * gg[9]); w1.y = pk2h(v[10] * rs * gg[10], v[11] * rs * gg[11]); w1.z = pk2h(v[12] * rs * gg[12], v[13] * rs * gg[13]); w1.w = pk2h(v[14] * rs * gg[14], v[15] * rs * gg[15]);
        *(u32x4*)(OR + (size_t)m * DM + lane * 16) = w0; *(u32x4*)(OR + (size_t)m * DM + lane * 16 + 8) = w1;
        cur = nxt; m = nx;
    }
#undef MIX_LOAD
}


namespace att {
typedef short s16x4 __attribute__((ext_vector_type(4)));
typedef float f32x16 __attribute__((ext_vector_type(16)));
constexpr int TILE_K = 12288, TILE_V = 8192, SLOT_K = 2 * TILE_K, SLOT_V = 2 * TILE_V;
constexpr int L_K = 0, L_V = 2 * SLOT_K, L_WS = L_V + 2 * SLOT_V, L_OST = L_WS + 8 * 256, L_FLAG = L_OST + 8 * 4096, L_END = L_FLAG + 64;
constexpr float THR = 8.0f, BIGM = 30000.0f;
struct AU {
    const f16 *q, *k, *v; f16* o; float* ml; const float* kmean;
    int qs, ks, vs, os, mls;
    int t_lo, t_hi, qb; float slope2, sink2;
    unsigned tkoff;
    const unsigned short* list; int nrows, nnext, par, jblk, last, kvres; f16 *pa01, *pa2; float* paml; int h;
};
constexpr int L_ENT = L_END;
constexpr int L_END2 = L_ENT + 2048;
__device__ __forceinline__ int crow(int r, int hi) { return (r & 3) + 8 * (r >> 2) + 4 * hi; }
__device__ __forceinline__ void glds16(const void* gsrc, unsigned lds_dst) { unsigned keep;
    asm volatile("s_mov_b32 %0, m0\n\ts_mov_b32 m0, %2\n\ts_nop 0\n\tglobal_load_lds_dwordx4 %1, off\n\ts_mov_b32 m0, %0" : "=&s"(keep) : "v"(gsrc), "s"(lds_dst) : "memory"); }
__device__ __forceinline__ unsigned rfl(unsigned x) { return (unsigned)__builtin_amdgcn_readfirstlane((int)x); }
typedef short v4i16_t __attribute__((ext_vector_type(4)));
__device__ __forceinline__ s16x4 vtr(const LAS unsigned char* p) { return __builtin_bit_cast(s16x4, __builtin_amdgcn_ds_read_tr16_b64_v4i16((LAS v4i16_t*)p)); }
__device__ __forceinline__ unsigned pkh(float lo, float hi) { return __builtin_bit_cast(unsigned, __builtin_convertvector((f32x2){lo, hi}, h2)); }
__device__ __forceinline__ unsigned pk_hilo(float x) { const f16 h = (f16)x; const f16 l = (f16)((x - (float)h) * 1024.0f); return (unsigned)__builtin_bit_cast(unsigned short, h) | ((unsigned)__builtin_bit_cast(unsigned short, l) << 16); }
__device__ __forceinline__ unsigned pk_hilo64(float x) { const f16 h = (f16)x; const f16 l = (f16)((x - (float)h) * 1024.0f); const f16 h64 = (f16)((float)h * 64.0f), l64 = (f16)((float)l * 64.0f);
    return (unsigned)__builtin_bit_cast(unsigned short, h64) | ((unsigned)__builtin_bit_cast(unsigned short, l64) << 16); }
__device__ __forceinline__ float rowmax32(const f32x16& p0, const f32x16& p1) {
    float a = fmaxf(fmaxf(p0[0], p0[1]), p1[0]), b = fmaxf(fmaxf(p0[2], p0[3]), p1[1]); a = fmaxf(fmaxf(a, p1[2]), p1[3]);
#pragma unroll
    for (int r = 4; r < 16; r += 4) { a = fmaxf(fmaxf(a, p0[r]), p0[r + 1]); b = fmaxf(fmaxf(b, p0[r + 2]), p0[r + 3]); a = fmaxf(fmaxf(a, p1[r]), p1[r + 1]); b = fmaxf(fmaxf(b, p1[r + 2]), p1[r + 3]); }
    return fmaxf(a, b);
}
#define ATT_WAITBAR(N) asm volatile("s_waitcnt vmcnt(" #N ") lgkmcnt(0)\n\ts_barrier" ::: "memory")

template <int DQK, int MK, bool MOBA, bool SINK, bool PART, int W, bool GATH = false>
__device__ __forceinline__ void attn_unit(LAS unsigned char* lds, const AU& u, unsigned* qctr, unsigned& nxt) {
    constexpr int ND = DQK / 16; constexpr bool EXT = (DQK == 64);
    int tid_ = threadIdx.x; asm volatile("" : "+v"(tid_));
    const int tid = tid_, lane = tid & 63, r32 = lane & 31, hi = lane >> 5; const int wid = __builtin_amdgcn_readfirstlane(tid >> 6);
    const unsigned lds0 = (unsigned)(uintptr_t)lds;
    LAS float* wsf = (LAS float*)(lds + L_WS) + wid * 64;
    const int qi = 32 * wid + r32;
    LAS unsigned* ent = (LAS unsigned*)(lds + L_ENT) + (GATH ? 256 * u.par : 0);
    unsigned e_next = 0u;
    int tq_ = 0;
    if constexpr (GATH) {
        if (!u.kvres) {
            if (tid < 256) { unsigned e = (unsigned)u.list[tid < u.nrows ? tid : 0]; if (tid >= u.nrows) e |= 0x8000u; ent[tid] = e; }
            asm volatile("s_waitcnt vmcnt(0) lgkmcnt(0)\n\ts_barrier" ::: "memory"); }
        if (u.nnext > 0 && tid < 256) { e_next = (unsigned)u.list[256 + (tid < u.nnext ? tid : 0)]; if (tid >= u.nnext) e_next |= 0x8000u; }
        tq_ = (int)(ent[qi] & 0x1fffu);
    }
#define ATT_DMA1(t, kdst, vdst, XW) do { const long kk0_ = (long)(t) * 64; \
        glds16(u.k + (kk0_ + lane) * (long)u.ks + 8 * wid, rfl(lds0 + (kdst) + wid * 1024)); \
        if (DQK == 96 && (XW)) glds16(u.k + (kk0_ + lane) * (long)u.ks + 64 + 8 * (wid & 3), rfl(lds0 + (kdst) + (8 + (wid & 3)) * 1024)); \
        glds16(u.v + (kk0_ + 16 * (wid & 3) + (lane >> 2)) * (long)u.vs + 32 * (wid >> 2) + 8 * (lane & 3), rfl(lds0 + (vdst) + wid * 1024)); } while (0)
#define ATT_DMA(t, slot) do { ATT_DMA1((t), L_K + (slot) * SLOT_K, L_V + (slot) * SLOT_V, wid < 4); ATT_DMA1((t) + 1, L_K + (slot) * SLOT_K + TILE_K, L_V + (slot) * SLOT_V + TILE_V, wid >= 4); } while (0)
    if (!(GATH && u.kvres)) ATT_DMA(u.t_lo, 0);
    h8 qr[ND];
    { const f16* qrow = u.q + (long)(GATH ? tq_ : qi) * u.qs + 8 * hi;
#pragma unroll
      for (int d0 = 0; d0 < ND; ++d0) qr[d0] = *(const h8*)(qrow + 16 * d0);
#pragma unroll
      for (int d0 = 0; d0 < ND; ++d0) asm volatile("" : "+v"(qr[d0])); }
    unsigned selmask = 0u;
    if constexpr (MOBA) {
        LAS float* kms = (LAS float*)(lds + L_OST);
        for (int i = tid; i < u.qb * 64; i += 512) kms[i] = u.kmean[(size_t)(i >> 6) * 256 + (i & 63)];
        float qf[64];
        { const f16* qrow = u.q + (long)qi * u.qs;
#pragma unroll
          for (int c = 0; c < 8; ++c) { const h8 v = *(const h8*)(qrow + 8 * c);
#pragma unroll
              for (int j = 0; j < 8; ++j) qf[8 * c + j] = (float)v[j]; } }
        asm volatile("s_waitcnt lgkmcnt(0)\n\ts_barrier" ::: "memory");
        float v1 = -INFINITY, v2 = -INFINITY, v3 = -INFINITY; int i1 = -1, i2 = -1, i3 = -1;
        for (int j = 0; j < u.qb; ++j) {
            float g0 = 0.f, g1 = 0.f;
#pragma unroll
            for (int c = 0; c < 16; ++c) { const f32x4 kv = *(const LAS f32x4*)(kms + 64 * j + 4 * c); g0 += qf[4 * c] * kv[0] + qf[4 * c + 2] * kv[2]; g1 += qf[4 * c + 1] * kv[1] + qf[4 * c + 3] * kv[3]; }
            const float g = g0 + g1;
            if (g > v1) { v3 = v2; i3 = i2; v2 = v1; i2 = i1; v1 = g; i1 = j; } else if (g > v2) { v3 = v2; i3 = i2; v2 = g; i2 = j; } else if (g > v3) { v3 = g; i3 = j; }
        }
        if (i1 >= 0) selmask |= 1u << i1; if (i2 >= 0) selmask |= 1u << i2; if (i3 >= 0) selmask |= 1u << i3;
        selmask |= 1u << u.qb;
        asm volatile("s_waitcnt lgkmcnt(0)\n\ts_barrier" ::: "memory");
    }
    f32x16 pinit = f32x16{};
    float dlt = 0.f, l_reg = 0.f; const float mh0 = EXT ? u.slope2 * (float)(GATH ? (tq_ - 256 * u.jblk) : qi) : 0.f;
    f32x16 o[2]; o[0] = f32x16{}; o[1] = f32x16{};
    u32x4 kx0 = {0u, 0u, 0u, 0u}, kx1 = {0u, 0u, 0u, 0u}, qx = {0u, 0u, 0u, 0u};
    if constexpr (EXT) {
        kx0.x = pkh((float)r32, (float)r32 * (1.0f / 1024.0f)); kx1.x = pkh((float)(r32 + 32), (float)(r32 + 32) * (1.0f / 1024.0f));
        kx0.z = kx1.z = pkh(-1.0f, -1.0f / 1024.0f);
        qx.x = hi ? 0u : pk_hilo(u.slope2); qx.y = hi ? 0u : pk_hilo64(u.slope2); qx.z = hi ? 0u : pk_hilo(mh0);
    }
    const LAS unsigned char* vbase = lds + L_V + ((lane >> 4) & 1) * 32 + (lane & 3) * 8 + (4 * hi + ((lane & 15) >> 2)) * 64;
    const LAS unsigned char* kbase = lds + L_K + hi * 1024 + r32 * 16;
    ATT_WAITBAR(0);
    int slot = 0; int cur_blk = -1000; bool rowsel = true;
    for (int t = u.t_lo; t < u.t_hi; t += 2) {
        const bool more = (t + 2 < u.t_hi);
        bool active = true;
        if constexpr (MK == 0) { if (t >= 0 && 64 * t > 32 * wid + 31) active = false; }
        else if constexpr (MK == 1) { if (64 * t > 32 * wid + 31 || 64 * t + 127 < 32 * wid - W) active = false; }
        if constexpr (MOBA) {
            const int blk = u.qb + (t >> 2);
            if (blk != cur_blk) { cur_blk = blk; rowsel = ((selmask >> blk) & 1u) != 0u;
                const float mh = rowsel ? (mh0 + dlt) : BIGM; qx.z = hi ? 0u : pk_hilo(mh); }
            if (!__any(rowsel)) active = false;
        }
        if (more && !(GATH && u.kvres) && (wid < 4 || !active)) ATT_DMA(t + 2, slot ^ 1);
        if (active) {
            const LAS unsigned char* Ks = kbase + slot * SLOT_K;
            f32x16 p0 = EXT ? f32x16{} : pinit, p1 = p0, p2 = p0, p3 = p0;
            constexpr int NBF = 2;
            constexpr int NBATCH = 2 * ND / NBF;
            h8 kc[2 * NBF], kn[2 * NBF];
#define ATT_KLOAD(dst, bi) do { const int tile_ = ((bi) * NBF) / ND, d0b_ = ((bi) * NBF) % ND; \
                _Pragma("unroll") for (int j = 0; j < NBF; ++j) { dst[2 * j] = *(const LAS h8*)(Ks + tile_ * TILE_K + (d0b_ + j) * 2048); dst[2 * j + 1] = *(const LAS h8*)(Ks + tile_ * TILE_K + (d0b_ + j) * 2048 + 512); } } while (0)
            ATT_KLOAD(kc, 0);
#pragma unroll
            for (int bi = 0; bi < NBATCH; ++bi) {
                if (bi + 1 < NBATCH) ATT_KLOAD(kn, bi + 1);
                __builtin_amdgcn_sched_barrier(0);
                const int tile_ = (bi * NBF) / ND, d0b_ = (bi * NBF) % ND;
#pragma unroll
                for (int j = 0; j < NBF; ++j) {
                    if (tile_ == 0) { p0 = __builtin_amdgcn_mfma_f32_32x32x16_f16(kc[2 * j], qr[d0b_ + j], p0, 0, 0, 0); p1 = __builtin_amdgcn_mfma_f32_32x32x16_f16(kc[2 * j + 1], qr[d0b_ + j], p1, 0, 0, 0); }
                    else            { p2 = __builtin_amdgcn_mfma_f32_32x32x16_f16(kc[2 * j], qr[d0b_ + j], p2, 0, 0, 0); p3 = __builtin_amdgcn_mfma_f32_32x32x16_f16(kc[2 * j + 1], qr[d0b_ + j], p3, 0, 0, 0); }
                }
                __builtin_amdgcn_sched_barrier(0);
#pragma unroll
                for (int j = 0; j < 2 * NBF; ++j) kc[j] = kn[j];
            }
#undef ATT_KLOAD
            if constexpr (EXT) { kx0.y = kx1.y = pkh((float)t, (float)t * (1.0f / 1024.0f));
                p0 = __builtin_amdgcn_mfma_f32_32x32x16_f16(__builtin_bit_cast(h8, kx0), __builtin_bit_cast(h8, qx), p0, 0, 0, 0);
                p1 = __builtin_amdgcn_mfma_f32_32x32x16_f16(__builtin_bit_cast(h8, kx1), __builtin_bit_cast(h8, qx), p1, 0, 0, 0);
                u32x4 ky0 = kx0, ky1 = kx1; ky0.y = ky1.y = pkh((float)(t + 1), (float)(t + 1) * (1.0f / 1024.0f));
                p2 = __builtin_amdgcn_mfma_f32_32x32x16_f16(__builtin_bit_cast(h8, ky0), __builtin_bit_cast(h8, qx), p2, 0, 0, 0);
                p3 = __builtin_amdgcn_mfma_f32_32x32x16_f16(__builtin_bit_cast(h8, ky1), __builtin_bit_cast(h8, qx), p3, 0, 0, 0); }
            if (more && !(GATH && u.kvres) && wid >= 4) ATT_DMA(t + 2, slot ^ 1);
            if (wid >= 4) __builtin_amdgcn_s_setprio(1);
            if constexpr (MK == 0) { if (t + 1 >= 0) { const int kb = 64 * t + 4 * hi;
#pragma unroll
                for (int r = 0; r < 16; ++r) { const int kv = kb + (r & 3) + 8 * (r >> 2); if (kv > qi) p0[r] = -INFINITY; if (kv + 32 > qi) p1[r] = -INFINITY; if (kv + 64 > qi) p2[r] = -INFINITY; if (kv + 96 > qi) p3[r] = -INFINITY; } } }
            else if constexpr (MK == 1) { const int rb = qi - 64 * t - 4 * hi;
#pragma unroll
                for (int r = 0; r < 16; ++r) { const int rel = rb - ((r & 3) + 8 * (r >> 2)); if ((unsigned)rel > (unsigned)W) p0[r] = -INFINITY; if ((unsigned)(rel - 32) > (unsigned)W) p1[r] = -INFINITY;
                    if ((unsigned)(rel - 64) > (unsigned)W) p2[r] = -INFINITY; if ((unsigned)(rel - 96) > (unsigned)W) p3[r] = -INFINITY; } }
            float rm = fmaxf(rowmax32(p0, p1), rowmax32(p2, p3));
            { const auto rr = __builtin_amdgcn_permlane32_swap(__float_as_uint(rm), __float_as_uint(rm), false, false); rm = fmaxf(__uint_as_float(rr[0]), __uint_as_float(rr[1])); }
            if (__builtin_expect(__any(rm > THR), 0)) {
                const float dl = fmaxf(rm, 0.f); dlt += dl;
#pragma unroll
                for (int r = 0; r < 16; ++r) { p0[r] -= dl; p1[r] -= dl; p2[r] -= dl; p3[r] -= dl; }
                const float f = __builtin_amdgcn_exp2f(-dl); l_reg *= f;
                if (hi == 0) wsf[r32] = f;
                asm volatile("s_waitcnt lgkmcnt(0)" ::: "memory");
#pragma unroll
                for (int d_ = 0; d_ < 2; ++d_)
#pragma unroll
                    for (int r = 0; r < 16; ++r) o[d_][r] *= wsf[crow(r, hi)];
                if constexpr (EXT) { const float mh = (MOBA && !rowsel) ? BIGM : (mh0 + dlt); qx.z = hi ? 0u : pk_hilo(mh); }
                else {
#pragma unroll
                    for (int r = 0; r < 16; ++r) pinit[r] = -dlt; }
            }
            const LAS unsigned char* Vs = vbase + slot * SLOT_V;
#define ATT_VLOAD(lo, hv, VOFF) do { _Pragma("unroll") for (int i_ = 0; i_ < 4; ++i_) { lo[i_] = vtr(Vs + (VOFF) + i_ * 1024); hv[i_] = vtr(Vs + (VOFF) + i_ * 1024 + 512); } } while (0)
#define ATT_VF(lo, hv, i) __builtin_bit_cast(h8, (short __attribute__((ext_vector_type(8)))){lo[i][0], lo[i][1], lo[i][2], lo[i][3], hv[i][0], hv[i][1], hv[i][2], hv[i][3]})
#define ATT_EXPPACK(PA, PB, W0, W1, W2, W3) do { \
            _Pragma("unroll") for (int r = 0; r < 16; ++r) { PA[r] = __builtin_amdgcn_exp2f(PA[r]); PB[r] = __builtin_amdgcn_exp2f(PB[r]); } \
            float sacc = 0.f; _Pragma("unroll") for (int r = 0; r < 16; ++r) sacc += PA[r] + PB[r]; \
            l_reg += sacc; \
            W0 = (u32x4){pkh(PA[0], PA[1]), pkh(PA[2], PA[3]), pkh(PA[4], PA[5]), pkh(PA[6], PA[7])}; \
            W1 = (u32x4){pkh(PA[8], PA[9]), pkh(PA[10], PA[11]), pkh(PA[12], PA[13]), pkh(PA[14], PA[15])}; \
            W2 = (u32x4){pkh(PB[0], PB[1]), pkh(PB[2], PB[3]), pkh(PB[4], PB[5]), pkh(PB[6], PB[7])}; \
            W3 = (u32x4){pkh(PB[8], PB[9]), pkh(PB[10], PB[11]), pkh(PB[12], PB[13]), pkh(PB[14], PB[15])}; } while (0)
#define ATT_PV(D0, lo, hv, W0, W1, W2, W3) do { \
                o[D0] = __builtin_amdgcn_mfma_f32_32x32x16_f16(__builtin_bit_cast(h8, W0), ATT_VF(lo, hv, 0), o[D0], 0, 0, 0); \
                o[D0] = __builtin_amdgcn_mfma_f32_32x32x16_f16(__builtin_bit_cast(h8, W1), ATT_VF(lo, hv, 1), o[D0], 0, 0, 0); \
                o[D0] = __builtin_amdgcn_mfma_f32_32x32x16_f16(__builtin_bit_cast(h8, W2), ATT_VF(lo, hv, 2), o[D0], 0, 0, 0); \
                o[D0] = __builtin_amdgcn_mfma_f32_32x32x16_f16(__builtin_bit_cast(h8, W3), ATT_VF(lo, hv, 3), o[D0], 0, 0, 0); } while (0)
            {
                s16x4 l0[4], h0[4], l1[4], h1[4]; u32x4 wa0, wa1, wa2, wa3, wb0, wb1, wb2, wb3;
                ATT_VLOAD(l0, h0, 0);
                __builtin_amdgcn_sched_barrier(0);
                ATT_EXPPACK(p0, p1, wa0, wa1, wa2, wa3);
                ATT_VLOAD(l1, h1, 4096);
                __builtin_amdgcn_sched_barrier(0);
                ATT_PV(0, l0, h0, wa0, wa1, wa2, wa3);
                ATT_EXPPACK(p2, p3, wb0, wb1, wb2, wb3);
                __builtin_amdgcn_s_setprio(0);
                __builtin_amdgcn_sched_barrier(0);
                ATT_VLOAD(l0, h0, TILE_V);
                __builtin_amdgcn_sched_barrier(0);
                ATT_PV(1, l1, h1, wa0, wa1, wa2, wa3);
                __builtin_amdgcn_sched_barrier(0);
                ATT_VLOAD(l1, h1, TILE_V + 4096);
                __builtin_amdgcn_sched_barrier(0);
                ATT_PV(0, l0, h0, wb0, wb1, wb2, wb3);
                __builtin_amdgcn_sched_barrier(0);
                ATT_PV(1, l1, h1, wb0, wb1, wb2, wb3);
            }
#undef ATT_VLOAD
#undef ATT_VF
#undef ATT_EXPPACK
#undef ATT_PV
        }
        ATT_WAITBAR(0);
        slot ^= 1;
    }
    if (threadIdx.x == 0 && (!GATH || u.last)) nxt = u.tkoff + __hip_atomic_fetch_add(qctr, 1u, __ATOMIC_RELAXED, __HIP_MEMORY_SCOPE_AGENT);
    { const auto rr = __builtin_amdgcn_permlane32_swap(__float_as_uint(l_reg), __float_as_uint(l_reg), false, false); l_reg = __uint_as_float(rr[0]) + __uint_as_float(rr[1]); }
    if constexpr (GATH) { const unsigned e = ent[qi]; if (hi == 0 && !(e & 0x8000u)) *(f32x2*)(u.paml + ((size_t)((e >> 13) & 3u) * T * 4 + (size_t)(e & 0x1fffu) * 4) * 2) = (f32x2){dlt, l_reg}; }
    else if constexpr (PART) { if (hi == 0) *(f32x2*)(u.ml + (long)qi * u.mls) = (f32x2){dlt, l_reg}; }
    if constexpr (SINK) l_reg += __builtin_amdgcn_exp2f(u.sink2 - dlt);
    if (hi == 0) wsf[32 + r32] = l_reg;
    asm volatile("s_waitcnt lgkmcnt(0)" ::: "memory");
    float rli[16];
#pragma unroll
    for (int r = 0; r < 16; ++r) rli[r] = __builtin_amdgcn_rcpf(wsf[32 + crow(r, hi)]);
    { LAS f16* stg = (LAS f16*)(lds + L_OST) + wid * 2048;
#pragma unroll
      for (int r = 0; r < 16; ++r) { const int orow = crow(r, hi);
#pragma unroll
          for (int d0 = 0; d0 < 2; ++d0) stg[orow * 64 + d0 * 32 + r32] = (f16)(o[d0][r] * rli[r]); }
      asm volatile("s_waitcnt lgkmcnt(0)" ::: "memory");
#pragma unroll
      for (int i = 0; i < 4; ++i) { const int row = i * 8 + (lane >> 3), ch = lane & 7; const u32x4 v = *(const LAS u32x4*)(stg + row * 64 + ch * 8);
          if constexpr (GATH) { const unsigned e = ent[32 * wid + row]; const unsigned sl = (e >> 13) & 3u; f16* pb = (sl == 2u) ? u.pa2 : u.pa01 + (size_t)sl * T * 256;
              if (!(e & 0x8000u)) *(u32x4*)(pb + (size_t)(e & 0x1fffu) * 256 + ch * 8) = v; }
          else *(u32x4*)(u.o + (long)(32 * wid + row) * u.os + ch * 8) = v; } }
    if constexpr (GATH) { if (u.nnext > 0 && tid < 256) ((LAS unsigned*)(lds + L_ENT) + 256 * (u.par ^ 1))[tid] = e_next; }
    asm volatile("s_waitcnt lgkmcnt(0)\n\ts_barrier" ::: "memory");
#undef ATT_DMA
#undef ATT_DMA1
}
}

template <int D> __device__ __forceinline__ float dotq(const float (&q)[D], const f16* kr) {
    float s0 = 0.f, s1 = 0.f;
#pragma unroll
    for (int c = 0; c < D / 8; ++c) { const h8 kv = *(const h8*)(kr + 8 * c);
#pragma unroll
        for (int j = 0; j < 8; j += 2) { s0 += q[8 * c + j] * (float)kv[j]; s1 += q[8 * c + j + 1] * (float)kv[j + 1]; } }
    return s0 + s1;
}
__device__ __forceinline__ void axpy64(float (&o)[64], float p, const f16* vr) {
#pragma unroll
    for (int c = 0; c < 8; ++c) { const h8 vv = *(const h8*)(vr + 8 * c);
#pragma unroll
        for (int j = 0; j < 8; ++j) o[8 * c + j] += p * (float)vv[j]; }
}
template <int D> __device__ __forceinline__ void loadq(float (&q)[D], const f16* qr) {
#pragma unroll
    for (int c = 0; c < D / 8; ++c) { const h8 v = *(const h8*)(qr + 8 * c);
#pragma unroll
        for (int j = 0; j < 8; ++j) q[8 * c + j] = (float)v[j]; }
}
__device__ __forceinline__ void store64(f16* orow, const float (&o)[64], float inv) {
#pragma unroll
    for (int c = 0; c < 8; ++c) { u32x4 w; w.x = pk2h(o[8 * c] * inv, o[8 * c + 1] * inv); w.y = pk2h(o[8 * c + 2] * inv, o[8 * c + 3] * inv); w.z = pk2h(o[8 * c + 4] * inv, o[8 * c + 5] * inv); w.w = pk2h(o[8 * c + 6] * inv, o[8 * c + 7] * inv);
        *(u32x4*)(orow + 8 * c) = w; }
}
#define KEYSTEP(DQ, vld_, bias_, krow_, vrow_) do { const bool vld = (vld_); const float s = dotq<DQ>(q, (krow_)) + (bias_); \
    if (__any(vld && s > m)) { const float mn = vld ? fmaxf(m, s) : m; const float f = __builtin_amdgcn_exp2f(m - mn); l *= f; _Pragma("unroll") for (int d_ = 0; d_ < 64; ++d_) o[d_] *= f; m = mn; } \
    const float p = vld ? __builtin_amdgcn_exp2f(s - m) : 0.f; l += p; axpy64(o, p, (vrow_)); } while (0)

__device__ __forceinline__ float alibi_slope(int idx) { return exp2f((-8.0f * (float)idx) / 12.0f); }

__device__ __forceinline__ void valu_moba(Frame& F, int b, int h, int c) {
    const int lane = lane_id(); const f16* HB = (const f16*)(F.ws + WS_HB); const float* KMP = (const float*)(F.ws + WS_KMP); f16* OR = (f16*)(F.ws + WS_OR);
    const int t = 64 * c + lane; const size_t row = (size_t)b * SEQ + t; const int qblk = c >> 2;
    float q[64]; loadq<64>(q, HB + row * HBP + C_AQ + 64 * h);
    float v1 = -INFINITY, v2 = -INFINITY, v3 = -INFINITY; int i1 = -1, i2 = -1, i3 = -1;
    for (int j = 0; j < qblk; ++j) {
        const float* k0 = KMP + ((size_t)(b * 32 + j) * 4 + h) * 256;
        float g = 0.f;
#pragma unroll
        for (int d = 0; d < 64; ++d) g += q[d] * ((k0[d] + k0[64 + d]) + (k0[128 + d] + k0[192 + d]));
        if (g > v1) { v3 = v2; i3 = i2; v2 = v1; i2 = i1; v1 = g; i1 = j; } else if (g > v2) { v3 = v2; i3 = i2; v2 = g; i2 = j; } else if (g > v3) { v3 = g; i3 = j; }
    }
    unsigned sel = 0u; if (i1 >= 0) sel |= 1u << i1; if (i2 >= 0) sel |= 1u << i2; if (i3 >= 0) sel |= 1u << i3;
    const float sl2 = alibi_slope(1 + 3 * h) * LOG2E;
    float o[64]; float m = -1e30f, l = 0.f;
#pragma unroll
    for (int d = 0; d < 64; ++d) o[d] = 0.f;
    for (int j = 0; j <= qblk; ++j) {
        const bool mine = (j == qblk) || ((sel >> j) & 1u);
        if (!__any(mine)) continue;
        const int kend = (j == qblk) ? min(256, 64 * (c & 3) + 64) : 256;
        for (int kk = 0; kk < kend; ++kk) { const int kpos = 256 * j + kk; const f16* kr = HB + ((size_t)b * SEQ + kpos) * HBP;
            KEYSTEP(64, mine && kpos <= t, sl2 * (float)(kpos - t), kr + C_AK + 64 * h, kr + C_AV + 64 * h); }
    }
    store64(OR + row * DM + 0 + 64 * h, o, 1.0f / l);
}
__device__ __forceinline__ void valu_mla(Frame& F, int b, int h, int c) {
    const int lane = lane_id(); const f16* QB = (const f16*)(F.ws + WS_QB); const f16* KB = (const f16*)(F.ws + WS_KB); const f16* VB = (const f16*)(F.ws + WS_VB); f16* OR = (f16*)(F.ws + WS_OR);
    const int t = 64 * c + lane; const size_t row = (size_t)b * SEQ + t;
    float q[96]; loadq<96>(q, QB + row * 384 + 96 * h);
    float o[64]; float m = -1e30f, l = 0.f;
#pragma unroll
    for (int d = 0; d < 64; ++d) o[d] = 0.f;
    const int kend = 64 * c + 64;
    for (int kpos = 0; kpos < kend; ++kpos) { const size_t rk = (size_t)b * SEQ + kpos;
        KEYSTEP(96, kpos <= t, 0.f, KB + rk * 384 + 96 * h, VB + rk * 256 + 64 * h); }
    store64(OR + row * DM + 256 + 64 * h, o, 1.0f / l);
}
__device__ __forceinline__ void valu_dil(Frame& F, int b, int h, int br, int r, int n, int hf) {
    const int lane = lane_id(); const f16* HB = (const f16*)(F.ws + WS_HB); f16* CPO = (f16*)((unsigned char*)F.out + OUT_CPO); float* CPML = (float*)(F.ws + WS_CPML);
    const int d = (br == 0) ? 1 : (br == 1 ? 4 : 16);
    const int i = 64 * hf + lane; const int t = (128 * n + i) * d + r; const size_t row = (size_t)b * SEQ + t;
    float q[64]; loadq<64>(q, HB + row * HBP + C_CQ + 64 * h);
    const float sl2 = alibi_slope(2 + 3 * h) * LOG2E * (float)d;
    float o[64]; float m = -1e30f, l = 0.f;
#pragma unroll
    for (int dd = 0; dd < 64; ++dd) o[dd] = 0.f;
    for (int kidx = 64 * hf; kidx < 64 * hf + 192; ++kidx) { const int sp = 128 * (n - 1) + kidx; if (sp < 0) continue;
        const int kpos = sp * d + r; const int rel = i + 128 - kidx; const f16* kr = HB + ((size_t)b * SEQ + kpos) * HBP;
        KEYSTEP(64, rel >= 0 && rel <= 128, -sl2 * (float)rel, kr + C_CK + 64 * h, kr + C_CV + 64 * h); }
    store64(CPO + ((size_t)br * T + row) * 256 + 64 * h, o, 1.0f / l);
    *(f32x2*)(CPML + (((size_t)br * T + row) * 4 + h) * 2) = (f32x2){m, l};
}
__device__ __forceinline__ void valu_swa(Frame& F, const Args& args, int l_, int b, int hq, int n, int hf) {
    const int lane = lane_id(); const f16* HB = (const f16*)(F.ws + WS_HB); f16* OR = (f16*)(F.ws + WS_OR);
    const int kvh = hq >> 1; const int i = 64 * hf + lane; const int t = 128 * n + i; const size_t row = (size_t)b * SEQ + t;
    float q[64]; loadq<64>(q, HB + row * HBP + C_DQ + 64 * hq);
    const float sl2 = alibi_slope(3 + 3 * hq) * LOG2E;
    float o[64]; float m = -1e30f, l = 0.f;
#pragma unroll
    for (int dd = 0; dd < 64; ++dd) o[dd] = 0.f;
    for (int kidx = 64 * hf; kidx < 64 * hf + 192; ++kidx) { const int kpos = 128 * (n - 1) + kidx; if (kpos < 0) continue;
        const int rel = i + 128 - kidx; const f16* kr = HB + ((size_t)b * SEQ + kpos) * HBP;
        KEYSTEP(64, rel >= 0 && rel < 128, -sl2 * (float)rel, kr + C_DK + 64 * kvh, kr + C_DV + 64 * kvh); }
    const float sk = args.in[I_SINK][l_ * 4 + hq] * LOG2E; const float M = fmaxf(m, sk);
    const float f = __builtin_amdgcn_exp2f(m - M); const float den = l * f + __builtin_amdgcn_exp2f(sk - M);
    store64(OR + row * DM + 768 + 64 * hq, o, f / den);
}
__device__ __forceinline__ void phase_attn_valu(Frame& F, const Args& args, int l) {
    const int gw = __builtin_amdgcn_readfirstlane(F.vcu * NWAVES + wave_id()), NGW = F.G * NWAVES;
    constexpr int NB = 1024, NA = 1024, NC = 3072, ND = 1024;
    for (int u = gw; u < NB + NA + NC + ND; u += NGW) {
        int r = u;
        if (r < NB) { const int c = 127 - (r >> 3), bh = r & 7; if (ATT_VALU & 2) valu_mla(F, bh >> 2, bh & 3, c); continue; } r -= NB;
        if (r < NA) { const int c = 127 - (r >> 3), bh = r & 7; if (ATT_VALU & 1) valu_moba(F, bh >> 2, bh & 3, c); continue; } r -= NA;
        if (r < NC) { const int hf = r & 1, bh = (r >> 1) & 7, rn = (r >> 4) & 63, br = r >> 10; const int d = (br == 0) ? 1 : (br == 1 ? 4 : 16); const int nbk = 64 / d;
            if (ATT_VALU & 4) valu_dil(F, bh >> 2, bh & 3, br, rn / nbk, rn % nbk, hf); continue; } r -= NC;
        { const int hf = r & 1, bh = (r >> 1) & 7, n = r >> 4; if (ATT_VALU & 8) valu_swa(F, args, l, bh >> 2, bh & 3, n, hf); }
    }
}


__device__ __forceinline__ void phase_attn(Frame& F, const Args& args, int l, int rep) {
    const f16* HB = (const f16*)(F.ws + WS_HB); f16* OR = (f16*)(F.ws + WS_OR);
    unsigned* qctr = (unsigned*)(F.ws + WS_CTL) + 8192 + 64 * (l + 2 * rep);
    volatile LAS unsigned* flag = (volatile LAS unsigned*)(F.lds + att::L_FLAG);
    constexpr int NB = 256, NAP = 248, NAO = 256, NC = 768, ND = 256;
    const unsigned tkoff = (F.xlocal && F.G == 256) ? 256u : 0u;
    unsigned nxt = 0u;
    if (threadIdx.x == 0) nxt = tkoff ? (unsigned)F.cu : __hip_atomic_fetch_add(qctr, 1u, __ATOMIC_RELAXED, __HIP_MEMORY_SCOPE_AGENT);
    for (;;) {
        if (threadIdx.x == 0) flag[0] = nxt;
        __syncthreads();
        const int id = (int)__builtin_amdgcn_readfirstlane((int)flag[0]);
        __syncthreads();
        if (id >= NB + NAP + NAO + NC + ND) break;
#define ATT_TAKE() do { if (threadIdx.x == 0) nxt = tkoff + __hip_atomic_fetch_add(qctr, 1u, __ATOMIC_RELAXED, __HIP_MEMORY_SCOPE_AGENT); } while (0)
        att::AU u{}; u.tkoff = tkoff; int r = id;
        if (r < NB) {
            if (ATT_VALU & 2) { ATT_TAKE(); continue; }
            const int qb = 31 - (r >> 3), bh = r & 7, b = bh >> 2, h = bh & 3; const size_t row0 = (size_t)b * SEQ + 256 * qb;
            u.q = (const f16*)(F.ws + WS_QB) + row0 * 384 + 96 * h; u.k = (const f16*)(F.ws + WS_KB) + row0 * 384 + 96 * h; u.v = (const f16*)(F.ws + WS_VB) + row0 * 256 + 64 * h;
            u.o = OR + row0 * DM + 256 + 64 * h; u.qs = 384; u.ks = 384; u.vs = 256; u.os = DM; u.t_lo = -4 * qb; u.t_hi = 4; u.qb = qb;
            att::attn_unit<96, 0, false, false, false, 0>(F.lds, u, qctr, nxt); continue; }
        r -= NB;
        if (r < NAP) {
            if (ATT_VALU & 1) { ATT_TAKE(); continue; }
            const int j = r >> 3, bh = r & 7, b = bh >> 2, h = bh & 3;
            const int n = (int)__builtin_amdgcn_readfirstlane((int)__hip_atomic_load((unsigned*)(F.ws + WS_CTL) + CW_LCNT + l * 256 + bh * 32 + j, __ATOMIC_RELAXED, __HIP_MEMORY_SCOPE_AGENT));
            if (n <= 0) { ATT_TAKE(); continue; }
            const size_t rb = (size_t)b * SEQ, rk = rb + 256 * j;
            u.q = HB + rb * HBP + C_AQ + 64 * h; u.k = HB + rk * HBP + C_AK + 64 * h; u.v = HB + rk * HBP + C_AV + 64 * h;
            u.qs = HBP; u.ks = HBP; u.vs = HBP; u.t_lo = 0; u.t_hi = 4; u.jblk = j; u.h = h; u.slope2 = alibi_slope(1 + 3 * h) * LOG2E;
            u.pa01 = (f16*)(F.ws + WS_PA01) + rb * 256 + 64 * h; u.pa2 = (f16*)((unsigned char*)F.out + OUT_PA2) + rb * 256 + 64 * h; u.paml = (float*)(F.ws + WS_PAML) + (rb * 4 + h) * 2;
            const unsigned short* lb = (const unsigned short*)(F.ws + WS_LIST) + (size_t)bh * LIST_STRIDE + 256 * (31 * j - (j * (j - 1)) / 2);
            for (int c0 = 0; c0 < n; c0 += 256) { u.list = lb + c0; u.nrows = (n - c0 < 256) ? (n - c0) : 256; u.last = (c0 + 256 >= n) ? 1 : 0; u.kvres = (c0 > 0) ? 1 : 0; u.par = (c0 >> 8) & 1; { const int rem = n - c0 - 256; u.nnext = rem <= 0 ? 0 : (rem < 256 ? rem : 256); }
                att::attn_unit<64, 2, false, false, false, 0, true>(F.lds, u, qctr, nxt); }
            continue; }
        r -= NAP;
        if (r < NAO) {
            if (ATT_VALU & 1) { ATT_TAKE(); continue; }
            const int qb = 31 - (r >> 3), bh = r & 7, b = bh >> 2, h = bh & 3; const size_t row0 = (size_t)b * SEQ + 256 * qb;
            u.q = HB + row0 * HBP + C_AQ + 64 * h; u.k = HB + row0 * HBP + C_AK + 64 * h; u.v = HB + row0 * HBP + C_AV + 64 * h;
            u.o = OR + row0 * DM + 64 * h; u.qs = HBP; u.ks = HBP; u.vs = HBP; u.os = DM; u.t_lo = 0; u.t_hi = 4; u.qb = qb;
            u.ml = (float*)(F.ws + WS_PAML) + (((size_t)3 * T + row0) * 4 + h) * 2; u.mls = 8;
            u.slope2 = alibi_slope(1 + 3 * h) * LOG2E;
            att::attn_unit<64, 0, false, false, true, 0>(F.lds, u, qctr, nxt); continue; }
        r -= NAO;
        if (r < NC) {
            if (ATT_VALU & 4) { ATT_TAKE(); continue; }
            const int br = r >> 8, rest = r & 255, bh = rest & 7, un = rest >> 3, b = bh >> 2, h = bh & 3; const int d = (br == 0) ? 1 : (br == 1 ? 4 : 16); const int per = 32 / d;
            const int res = un / per, ublk = un % per; const size_t row0 = (size_t)b * SEQ + (size_t)256 * ublk * d + res;
            u.q = HB + row0 * HBP + C_CQ + 64 * h; u.k = HB + row0 * HBP + C_CK + 64 * h; u.v = HB + row0 * HBP + C_CV + 64 * h;
            u.o = (f16*)((unsigned char*)F.out + OUT_CPO) + ((size_t)br * T + row0) * 256 + 64 * h; u.ml = (float*)(F.ws + WS_CPML) + (((size_t)br * T + row0) * 4 + h) * 2;
            u.qs = d * HBP; u.ks = d * HBP; u.vs = d * HBP; u.os = d * 256; u.mls = d * 8; u.t_lo = ublk ? -2 : 0; u.t_hi = 4;
            u.slope2 = alibi_slope(2 + 3 * h) * LOG2E * (float)d;
            att::attn_unit<64, 1, false, false, true, 128>(F.lds, u, qctr, nxt); continue; }
        r -= NC;
        {
            if (ATT_VALU & 8) { ATT_TAKE(); continue; }
            const int bh = r & 7, ublk = r >> 3, b = bh >> 2, hq = bh & 3, kvh = hq >> 1; const size_t row0 = (size_t)b * SEQ + 256 * ublk;
            u.q = HB + row0 * HBP + C_DQ + 64 * hq; u.k = HB + row0 * HBP + C_DK + 64 * kvh; u.v = HB + row0 * HBP + C_DV + 64 * kvh;
            u.o = OR + row0 * DM + 768 + 64 * hq; u.qs = HBP; u.ks = HBP; u.vs = HBP; u.os = DM; u.t_lo = ublk ? -2 : 0; u.t_hi = 4;
            u.slope2 = alibi_slope(3 + 3 * hq) * LOG2E; u.sink2 = args.in[I_SINK][l * 4 + hq] * LOG2E;
            att::attn_unit<64, 1, false, true, false, 127>(F.lds, u, qctr, nxt); }
#undef ATT_TAKE
    }
#if ATT_VALU
    phase_attn_valu(F, args, l);
#endif
    { unsigned* qc2 = qctr + 16;
        const int nsub = (l == 0) ? (cv::DEFER0 + cv::I_IN + cv::I_O + cv::I_UQ + cv::I_UKV) : (cv::I_UP + cv::I_DN);
        LAS float* scr = (LAS float*)(F.lds + wave_id() * 17408);
        volatile LAS unsigned* flag2 = (volatile LAS unsigned*)(F.lds + 146944 + 64);
        const int nconv2 = (nsub + 2 * NWAVES - 1) / (2 * NWAVES);
        auto lr = [&](int d, int& ll, int& rr) {
            if (l == 0) { if (d < cv::DEFER0) { ll = 0; rr = cv::I_IN + d; }
                          else { const int e = d - cv::DEFER0; ll = 1; rr = e < cv::I_IN + cv::I_O ? e : (cv::PER_L - cv::I_UQ - cv::I_UKV) + (e - cv::I_IN - cv::I_O); } }
            else { ll = 1; rr = cv::I_IN + cv::I_O + d; } };
        unsigned tk = 0u;
        if (threadIdx.x == 0) tk = __hip_atomic_fetch_add(qc2, 1u, __ATOMIC_RELAXED, __HIP_MEMORY_SCOPE_AGENT);
        for (;;) {
            __syncthreads();
            if (threadIdx.x == 0) flag2[0] = tk;
            __syncthreads();
            const int id = (int)__builtin_amdgcn_readfirstlane((int)flag2[0]);
            if (id >= nconv2) break;
            if (threadIdx.x == 0) tk = __hip_atomic_fetch_add(qc2, 1u, __ATOMIC_RELAXED, __HIP_MEMORY_SCOPE_AGENT);
            const int d0 = id * 2 * NWAVES + wave_id(), d1 = d0 + NWAVES;
            if (d0 < nsub) {
                int l0_, r0_; lr(d0, l0_, r0_); const TrA a0 = tr_args(F, args, l0_, r0_); f32x4 v0[16]; tr_load(a0, v0, lane_id());
                if (d1 < nsub) { int l1_, r1_; lr(d1, l1_, r1_); const TrA a1 = tr_args(F, args, l1_, r1_); f32x4 v1[16]; tr_load(a1, v1, lane_id());
                    tr_finish(a0, v0, scr, lane_id()); tr_finish(a1, v1, scr, lane_id()); }
                else tr_finish(a0, v0, scr, lane_id());
            }
        } }
}

typedef GAS unsigned gu32;
#define XB_TMO      128
#define XB_XCNT(j)  (256  + 64 * (j))
#define XB_XSUB(j)  (1280 + 64 * (j))
#define XB_XGEN(j)  (2304 + 64 * (j))
#define XB_TOP      3328
#define XB_TOPGEN   3392
#define XCD_BAR_WORDS 3456
#define XB_SPIN_CAP (1u << 22)
__device__ __forceinline__ unsigned xb_ld(unsigned* p)              { return __hip_atomic_load(p, __ATOMIC_RELAXED, __HIP_MEMORY_SCOPE_AGENT); }
__device__ __forceinline__ unsigned xb_add(unsigned* p, unsigned v) { return __hip_atomic_fetch_add(p, v, __ATOMIC_RELAXED, __HIP_MEMORY_SCOPE_AGENT); }
__device__ __forceinline__ unsigned xb_xcc_id() { return (unsigned)__builtin_amdgcn_s_getreg((3 << 11) | 20) & 0xFu; }
#define XB_SPIN(cond, bar) do { unsigned _sp = 0; while (cond) { __builtin_amdgcn_s_sleep(1); \
    if ((++_sp & 255u) == 0u) { if (xb_ld(&(bar)[XB_TMO])) break; if (_sp > XB_SPIN_CAP) { atomicAdd(&(bar)[XB_TMO], 1u); break; } } } } while (0)
struct XcdBarrier { unsigned* bar; unsigned x; volatile LAS unsigned* st; };
__device__ __forceinline__ XcdBarrier xcd_barrier_post(unsigned* bar, volatile LAS unsigned* st) {
    XcdBarrier b; b.bar = bar; b.x = xb_xcc_id(); b.st = st;
    if (threadIdx.x == 0) st[3] = xb_add(&bar[XB_XCNT(b.x)], 1u);
    return b;
}
__device__ __forceinline__ void xcd_barrier_complete(unsigned* bar, unsigned x, unsigned& nloc, unsigned& nx) {
    const unsigned G = gridDim.x * gridDim.y * gridDim.z;
    unsigned sum, cnt, mine, sp = 0u;
    for (;;) {
        sum = 0u; cnt = 0u; mine = 0u;
#pragma unroll
        for (unsigned j = 0; j < 16; ++j) { const unsigned c = xb_ld(&bar[XB_XCNT(j)]); sum += c; cnt += (c > 0u) ? 1u : 0u; mine = (j == x) ? c : mine; }
        if (sum == G) break;
        __builtin_amdgcn_s_sleep(1);
        if ((++sp & 255u) == 0u) { if (xb_ld(&bar[XB_TMO])) break; if (sp > XB_SPIN_CAP) { atomicAdd(&bar[XB_TMO], 1u); break; } }
    }
    nloc = mine > 0u ? mine : 1u; nx = cnt > 0u ? cnt : 1u;
}
__device__ __forceinline__ unsigned xcd_census_uniform(unsigned* bar) {
    const unsigned G = gridDim.x * gridDim.y * gridDim.z; unsigned ok = (G % 8u == 0u) ? 1u : 0u;
#pragma unroll
    for (unsigned j = 0; j < 16; ++j) { const unsigned c = xb_ld(&bar[XB_XCNT(j)]); if (c != (j < 8u ? G / 8u : 0u)) ok = 0u; }
    return ok;
}
__device__ __forceinline__ void xcd_barrier(const XcdBarrier& b) {
    asm volatile("s_waitcnt vmcnt(0)" ::: "memory");
    __syncthreads();
    if (threadIdx.x == 0) {
        unsigned* bar = b.bar;
        __builtin_amdgcn_s_waitcnt(0);
        unsigned nloc = b.st[0], nx = b.st[1];
        if (nloc == 0u) { xcd_barrier_complete(bar, b.x, nloc, nx); b.st[0] = nloc; b.st[1] = nx; }
        const unsigned old = xb_add(&bar[XB_XSUB(b.x)], 1u);
        const unsigned gen = old / nloc;
        if (old + 1u == (gen + 1u) * nloc) {
            __builtin_amdgcn_fence(__ATOMIC_RELEASE, "agent");
            asm volatile("s_waitcnt vmcnt(0)" ::: "memory");
            const unsigned og = xb_add(&bar[XB_TOP], 1u);
            const unsigned tg = og / nx;
            __builtin_amdgcn_fence(__ATOMIC_ACQUIRE, "agent");
            if (og + 1u == (tg + 1u) * nx) xb_add(&bar[XB_TOPGEN], 1u);
            else XB_SPIN(xb_ld(&bar[XB_TOPGEN]) == tg, bar);
            asm volatile("s_waitcnt vmcnt(0)" ::: "memory");
        } else {
            __builtin_amdgcn_fence(__ATOMIC_ACQUIRE, "agent");
            XB_SPIN(xb_ld(&bar[XB_TOPGEN]) == gen, bar);
            asm volatile("s_waitcnt vmcnt(0)" ::: "memory");
        }
    }
    __syncthreads();
}

__device__ __forceinline__ void xcd_local_barrier(const XcdBarrier& b, unsigned* lbar) {
    asm volatile("s_waitcnt vmcnt(0)" ::: "memory");
    __syncthreads();
    if (threadIdx.x == 0) {
        __builtin_amdgcn_s_waitcnt(0);
        const unsigned nloc = b.st[0];
        const unsigned old = xb_add(&lbar[64 * b.x], 1u);
        const unsigned gen = old / nloc;
        __builtin_amdgcn_fence(__ATOMIC_ACQUIRE, "agent");
        if (old + 1u == (gen + 1u) * nloc) xb_add(&lbar[1024 + 64 * b.x], 1u);
        else XB_SPIN(xb_ld(&lbar[1024 + 64 * b.x]) == gen, b.bar);
        asm volatile("s_waitcnt vmcnt(0)" ::: "memory");
    }
    __syncthreads();
}

#ifndef PHMASK
#define PHMASK 0xfff
#endif
#ifndef REPMASK
#define REPMASK 0
#endif
#define REP(k) for (int rep_ = 0; rep_ < (((REPMASK >> (k)) & 1) ? 2 : 1); ++rep_)
constexpr int PH_PER_LAYER = 11, N_PHASES = 1 + DEPTH * PH_PER_LAYER;
#define PH_FENCE() asm volatile("" ::: "memory")
#define PH_ENTER(k) do { if (P0 + (k) > lo) xcd_barrier(bar); PH_FENCE(); } while (0)
template <int L> __device__ __forceinline__ void run_layer(Frame& F, const Args& args, int lo, int hi, const XcdBarrier& bar) {
    constexpr int P0 = 1 + L * PH_PER_LAYER;
    const float* rs_in = (L == 0) ? (const float*)(F.ws + WS_RS) : (const float*)(F.ws + WS_XBUF) + (size_t)(2 * L - 1) * T * 4;
#define IN(k) (((PHMASK >> (k)) & 1) && lo <= P0 + (k) && P0 + (k) < hi)
    if (IN(0)) {
        PH_ENTER(0);
        pg8::Gemm g{(const f16*)(F.ws + WS_XN), wt_ptr(F, L, WO_IN), T, 2048, DM, DM}; pg8::StaticOrder S; S.init(T, 2048, F.G, F.cu);
        pg8::EpiIn E{(f16*)(F.ws + WS_HB), (const float*)wt_ptr(F, L, WO_GT), 0, rs_in, (float*)(F.ws + WS_LSS)};
        REP(0) { if (rep_) xcd_barrier(bar); pg8::gemm_phase<pg8::EpiIn, true, true>(F.lds, g, S, E); }
        { pg8::Unit u0; bool any = false; for (int i = 0; S.next(i, u0); ++i) if (u0.pn == 1) any = true;
          if (any) { VM_WAIT(); __syncthreads(); for (int i = 0; S.next(i, u0); ++i) if (u0.pn == 1) kmean_block(F, u0.pm); } } }
    if (IN(2)) {
        PH_ENTER(2);
        const int hg = F.G / 2;
        if (F.cu < hg) {
            pg8::Gemm g{(const f16*)(F.ws + WS_XN), wt_ptr(F, L, WO_IN) + (size_t)2048 * DM, T, 512, DM, DM}; pg8::StaticOrder S; S.init(T, 512, hg, F.cu);
            pg8::EpiIn E{(f16*)(F.ws + WS_HB), (const float*)wt_ptr(F, L, WO_GT), 8, rs_in, nullptr};
            pg8::gemm_phase<pg8::EpiIn, true, true>(F.lds, g, S, E);
            phase_mla_post(F, args, L, F.cu * NWAVES + wave_id(), hg * NWAVES, 0, 0, F.cu);
        } else {
            const int c = F.cu - hg; const float* ct = (const float*)(F.ws + WS_ROPE); const float* st = ct + SEQ * 16;
            { pg8::Gemm g{(const f16*)(F.ws + WS_HB) + C_QL, wt_ptr(F, L, WO_UQ), T, 512, 256, HBP}; pg8::StaticOrder S; S.init(T, 512, hg, c);
              pg8::EpiMlaQ E{(f16*)(F.ws + WS_QB), (const float*)(F.ws + WS_LSS), args.in[I_BQG] + L * 96, ct, st}; pg8::gemm_phase<pg8::EpiMlaQ, false, true>(F.lds, g, S, E); }
            __syncthreads();
            { pg8::Gemm g{(const f16*)(F.ws + WS_HB) + C_KVL, wt_ptr(F, L, WO_UKV), T, 512, 128, HBP}; pg8::StaticOrder S; S.init(T, 512, hg, c);
              pg8::EpiMlaKV E{(f16*)(F.ws + WS_KB), (f16*)(F.ws + WS_VB), (const f16*)(F.ws + WS_HB), (const float*)(F.ws + WS_LSS) + (size_t)T * 4, args.in[I_BKG] + L * 96, ct, st}; pg8::gemm_phase<pg8::EpiMlaKV, false, true>(F.lds, g, S, E); }
        } }
    if (IN(4)) { PH_ENTER(4); REP(4) { if (rep_) xcd_barrier(bar); phase_attn(F, args, L, rep_); } }
    if (IN(5)) { PH_ENTER(5); phase_mix(F, args, L); }
    if (IN(6)) {
        PH_ENTER(6);
        pg8::Gemm g{(const f16*)(F.ws + WS_OR), wt_ptr(F, L, WO_O), T, DM, DM, DM}; pg8::StaticOrder S; S.init(T, DM, F.G, F.cu);
        pg8::EpiResNorm E{(f16*)(F.ws + WS_XN), nullptr, (float*)(F.ws + WS_XBUF) + (size_t)(2 * L) * T * 4, 1};
        pg8::gemm_phase<pg8::EpiResNorm, false, true>(F.lds, g, S, E); }
    if (IN(8)) {
        if (P0 + 8 > lo) { if (F.xlocal) xcd_local_barrier(bar, (unsigned*)(F.ws + WS_CTL)); else xcd_barrier(bar); } PH_FENCE();
        pg8::Gemm g{(const f16*)(F.ws + WS_XN), wt_ptr(F, L, WO_UP), T, DFF, DM, DM}; pg8::StaticOrder S; S.init(T, DFF, F.G, F.cu);
        pg8::EpiF16<1> E{(f16*)(F.ws + WS_H), DFF, (const float*)(F.ws + WS_XBUF) + (size_t)(2 * L) * T * 4}; REP(8) { if (rep_) xcd_barrier(bar); pg8::gemm_phase<pg8::EpiF16<1>, true, true>(F.lds, g, S, E); } }
    if (IN(9)) {
        if (P0 + 9 > lo) { if (F.xlocal) xcd_local_barrier(bar, (unsigned*)(F.ws + WS_CTL)); else xcd_barrier(bar); } PH_FENCE();
        pg8::Gemm g{(const f16*)(F.ws + WS_H), wt_ptr(F, L, WO_DOWN), T, DM, DFF, DFF}; pg8::StaticOrder S; S.init(T, DM, F.G, F.cu);
        pg8::EpiResNorm E{(f16*)(F.ws + WS_XN), (L + 1 < DEPTH) ? nullptr : F.out, (float*)(F.ws + WS_XBUF) + (size_t)(2 * L + 1) * T * 4, (L + 1 < DEPTH) ? 1 : 0};
        pg8::gemm_phase<pg8::EpiResNorm, false, true>(F.lds, g, S, E); }
#undef IN
}
__global__ void __launch_bounds__(NWAVES * 64, 2) mega(Args args) {
    extern __shared__ __attribute__((aligned(16))) unsigned char lds_raw[];
    Frame F;
    F.lds = (LAS unsigned char*)lds_raw;
        F.G = gridDim.x; { const int bx = blockIdx.x; F.vcu = (F.G % 8 == 0) ? (bx % 8) * (F.G / 8) + bx / 8 : bx; }
    F.out = args.out; F.ws = args.ws;
    const int lo = args.ph_lo, hi = args.ph_hi;
    volatile LAS unsigned* MISC = (volatile LAS unsigned*)(F.lds + 146944);
    if (threadIdx.x < 32) MISC[threadIdx.x] = 0u;
    __syncthreads();
    XcdBarrier bar; bar.bar = (unsigned*)(F.ws + WS_CTL) + 4096; bar.x = 0; bar.st = nullptr;
    if (hi - lo > 1) bar = xcd_barrier_post((unsigned*)(F.ws + WS_CTL) + 4096, MISC + 8);
    if ((PHMASK & 0x800) && lo <= 0 && 0 < hi) REP(11) { if (rep_) xcd_barrier(bar); phase_prologue(F, args); }
    F.cu = (int)blockIdx.x; F.xlocal = 0;
    int lo0 = lo;
    if (lo <= 0 && hi > 2) {
        xcd_barrier(bar); PH_FENCE();
        if (threadIdx.x == 0) MISC[8 + 2] = xcd_census_uniform(bar.bar);
        __syncthreads();
        F.xlocal = (int)__builtin_amdgcn_readfirstlane((int)MISC[8 + 2]);
        if (F.xlocal) F.cu = (int)__builtin_amdgcn_readfirstlane((int)MISC[8 + 3]) * 8 + (int)bar.x;
        lo0 = 1;
    }
    run_layer<0>(F, args, lo0, hi, bar);
    run_layer<1>(F, args, lo, hi, bar);
}

extern "C" void kernel_launch(void* const* d_in, const int* in_sizes, int n_in, void* d_out, int out_size, void* d_ws, size_t ws_size, hipStream_t stream) {
    static int grid = 0;
    if (grid == 0) {
        if (n_in != 21 || out_size != T * DM || ws_size < WS_END) { fprintf(stderr, "kernel_launch: unexpected shapes (n_in %d, out %d, ws %zu)\n", n_in, out_size, ws_size); grid = -1; return; }
        if (hipFuncSetAttribute((const void*)mega, hipFuncAttributeMaxDynamicSharedMemorySize, LDS_BYTES) != hipSuccess) { fprintf(stderr, "kernel_launch: hipFuncSetAttribute failed\n"); grid = -1; return; }
        int dev = 0, cus = 0; hipGetDevice(&dev); hipDeviceGetAttribute(&cus, hipDeviceAttributeMultiprocessorCount, dev);
        int per_cu = 0;
        if (hipOccupancyMaxActiveBlocksPerMultiprocessor(&per_cu, (const void*)mega, NWAVES * 64, LDS_BYTES) != hipSuccess || per_cu < 1) fprintf(stderr, "kernel_launch: occupancy query reports %d blocks per CU\n", per_cu);
        (void)hipGetLastError();
        grid = cus > 0 ? cus : 256;
    }
    if (grid < 0) return;
    Args a{};
    for (int i = 0; i < 21; ++i) a.in[i] = (const float*)d_in[i];
    a.out = (float*)d_out; a.ws = (unsigned char*)d_ws;
#if defined(MK_MULTI)
    for (int ph = 0; ph < N_PHASES - 1; ++ph) {
        a.ph_lo = ph; a.ph_hi = ph + 1; a.li = ph;
        hipLaunchKernelGGL(mega, dim3(grid), dim3(NWAVES * 64), LDS_BYTES, stream, a);
    }
#else
    if (hipMemsetAsync((char*)d_ws + WS_CTL, 0, 131072, stream) != hipSuccess) { fprintf(stderr, "kernel_launch: hipMemsetAsync failed\n"); return; }
    a.ph_lo = 0; a.ph_hi = N_PHASES; a.li = 0;
    hipLaunchKernelGGL(mega, dim3(grid), dim3(NWAVES * 64), LDS_BYTES, stream, a);
#endif
}
```
